# Optimizing an MI355X kernel written in HIP

```python
import math
import jax, jax.numpy as jnp
from jax import lax
import numpy as np

D_MODEL = 2048
BATCH = 4
SEQ = 2048
DEPTH = 1
DEC_BATCH = 128
DEC_SEQ = 4
PAST_LEN = 16384
PAGE_SIZE = 128

D_CONV = D_MODEL // 2
N_CONV_GROUPS = 16
D_MLSTM = D_MODEL - D_CONV
N_HEADS = 4
HEAD_DIM = D_MLSTM // N_HEADS
CONV_K = 3
D_FF = 5632
CHUNK = 64
ALPHA = (2 * DEPTH) ** 0.25
BETA = (8 * DEPTH) ** -0.25
LN_EPS = 1e-5
IN_COLS = 3 * D_CONV + 4 * D_MLSTM + 2 * N_HEADS

kernel_name = "hymba_shortconv_mlstm_convffn_deepnorm_adaln_step"


def _layernorm(x):
    xf = x.astype(jnp.float32)
    mu = jnp.mean(xf, axis=-1, keepdims=True)
    var = jnp.mean(jnp.square(xf - mu), axis=-1, keepdims=True)
    return (xf - mu) * lax.rsqrt(var + LN_EPS)


def _causal_dwconv(x, buf, w):
    T = x.shape[1]
    xp = jnp.concatenate([buf.astype(x.dtype), x], axis=1)
    y = w[0] * xp[:, 0:T]
    for j in range(1, CONV_K):
        y = y + w[j] * xp[:, j:j + T]
    return y, xp[:, -(CONV_K - 1):]


def _mlstm(q, k, v, log_i, log_f, C0, n0, m0):
    Bsz, T = q.shape[0], q.shape[1]
    L = math.gcd(T, CHUNK)
    nc = T // L

    def to_chunks(a):
        a = a.reshape((Bsz, nc, L) + a.shape[2:])
        a = jnp.moveaxis(a, 1, 0)
        return jnp.swapaxes(a, 2, 3)

    qc, kc, vc = to_chunks(q), to_chunks(k), to_chunks(v)
    ic, fc = to_chunks(log_i), to_chunks(log_f)
    causal = jnp.tril(jnp.ones((L, L), dtype=bool))

    def step(carry, xs):
        C, n, m = carry
        qq, kk, vv, ii, ff = xs
        b = jnp.cumsum(ff, axis=-1)
        a = b + m[..., None]
        dlog = b[..., :, None] - b[..., None, :] + ii[..., None, :]
        dlog = jnp.where(causal, dlog, -jnp.inf)
        mt = jnp.maximum(a, jnp.max(dlog, axis=-1))
        dw = jnp.exp(dlog - mt[..., None])
        inter = jnp.exp(a - mt)
        s = jnp.einsum('bhtd,bhsd->bhts', qq, kk) * dw
        num = jnp.einsum('bhts,bhse->bhte', s, vv) + inter[..., None] * jnp.einsum('bhtd,bhde->bhte', qq, C)
        den = jnp.sum(s, axis=-1) + inter * jnp.einsum('bhtd,bhd->bht', qq, n)
        h = num / jnp.maximum(jnp.abs(den), jnp.exp(-mt))[..., None]
        m_new = mt[..., -1]
        wc = jnp.exp(b[..., -1:] - b + ii - m_new[..., None])
        dc = jnp.exp(a[..., -1] - m_new)
        C_new = dc[..., None, None] * C + jnp.einsum('bhs,bhsd,bhse->bhde', wc, kk, vv)
        n_new = dc[..., None] * n + jnp.einsum('bhs,bhsd->bhd', wc, kk)
        return (C_new, n_new, m_new), h

    (C, n, m), hs = lax.scan(step, (C0, n0, m0), (qc, kc, vc, ic, fc))
    h = jnp.swapaxes(hs, 2, 3)
    h = jnp.moveaxis(h, 0, 1).reshape(Bsz, T, N_HEADS, HEAD_DIM)
    return h, C, n, m


def _layer(x, c, conv_buf, C0, n0, m0, ffn_buf, w_ada, b_ada, w_in, b_gate, w_conv, w_mh_norm,
           w_out, ln1_g, ln1_b, w_up, w_ffn_conv, w_down, ln2_g, ln2_b):
    Bsz, T, _ = x.shape
    mod = jax.nn.silu(c.astype(jnp.float32)) @ w_ada + b_ada
    sh1, sc1, g1, sh2, sc2, g2 = [t[:, None, :] for t in jnp.split(mod, 6, axis=-1)]

    u = _layernorm(x) * (1.0 + sc1) + sh1
    p = u @ w_in
    cuts = [D_CONV, 2 * D_CONV, 3 * D_CONV,
            3 * D_CONV + D_MLSTM, 3 * D_CONV + 2 * D_MLSTM,
            3 * D_CONV + 3 * D_MLSTM, 3 * D_CONV + 4 * D_MLSTM]
    bg, cg, hc, q, k, v, o, gates = jnp.split(p, cuts, axis=-1)

    yc, conv_new = _causal_dwconv(cg * hc, conv_buf, w_conv)
    y_conv = bg * yc

    gates = gates + b_gate
    log_i = gates[..., :N_HEADS]
    log_f = jax.nn.log_sigmoid(gates[..., N_HEADS:])
    qh = q.reshape(Bsz, T, N_HEADS, HEAD_DIM).astype(jnp.float32)
    kh = k.reshape(Bsz, T, N_HEADS, HEAD_DIM).astype(jnp.float32) * (HEAD_DIM ** -0.5)
    vh = v.reshape(Bsz, T, N_HEADS, HEAD_DIM).astype(jnp.float32)
    hm, C1, n1, m1 = _mlstm(qh, kh, vh, log_i.astype(jnp.float32), log_f.astype(jnp.float32),
                            C0.astype(jnp.float32), n0.astype(jnp.float32), m0.astype(jnp.float32))
    hm = _layernorm(hm).reshape(Bsz, T, D_MLSTM) * w_mh_norm
    y_mlstm = jax.nn.sigmoid(o) * hm

    mix = jnp.concatenate([y_conv, y_mlstm], axis=-1) @ w_out
    x = _layernorm(ALPHA * x + (1.0 + g1) * mix) * ln1_g + ln1_b

    u2 = _layernorm(x) * (1.0 + sc2) + sh2
    up = u2 @ w_up
    a, g = jnp.split(up, 2, axis=-1)
    ac, ffn_new = _causal_dwconv(a, ffn_buf, w_ffn_conv)
    y = (jax.nn.silu(ac) * g) @ w_down
    x = _layernorm(ALPHA * x + (1.0 + g2) * y) * ln2_g + ln2_b
    return x, conv_new, C1, n1, m1, ffn_new


def setup_inputs(seed: int = 0) -> dict:
    key = jax.random.key(seed)
    ks = jax.random.split(key, 24)
    nrm = lambda k, s: jax.random.normal(k, s, dtype=jnp.float32)
    f_bias = jnp.linspace(3.0, 6.0, N_HEADS, dtype=jnp.float32)
    i_bias = jnp.full((N_HEADS,), -2.0, dtype=jnp.float32)
    b_gate = jnp.concatenate([i_bias, f_bias])[None, :] + 0.1 * nrm(ks[10], (DEPTH, 2 * N_HEADS))
    return {
        "x_prompt": nrm(ks[0], (BATCH, SEQ, D_MODEL)),
        "x_sample": nrm(ks[1], (DEC_BATCH, DEC_SEQ, D_MODEL)),
        "c_prompt": nrm(ks[2], (BATCH, D_MODEL)),
        "c_sample": nrm(ks[3], (DEC_BATCH, D_MODEL)),
        "state_conv": nrm(ks[4], (DEPTH, DEC_BATCH, CONV_K - 1, D_CONV)),
        "state_mlstm_C": 0.1 * nrm(ks[5], (DEPTH, DEC_BATCH, N_HEADS, HEAD_DIM, HEAD_DIM)),
        "state_mlstm_n": nrm(ks[6], (DEPTH, DEC_BATCH, N_HEADS, HEAD_DIM)),
        "state_mlstm_m": 0.5 * nrm(ks[7], (DEPTH, DEC_BATCH, N_HEADS)),
        "state_ffn_conv": nrm(ks[8], (DEPTH, DEC_BATCH, CONV_K - 1, D_FF)),
        "w_ada": 0.1 * D_MODEL ** -0.5 * nrm(ks[9], (DEPTH, D_MODEL, 6 * D_MODEL)),
        "b_ada": 0.02 * nrm(ks[11], (DEPTH, 6 * D_MODEL)),
        "w_in": D_MODEL ** -0.5 * nrm(ks[12], (DEPTH, D_MODEL, IN_COLS)),
        "b_gate": b_gate,
        "w_conv": CONV_K ** -0.5 * nrm(ks[13], (DEPTH, CONV_K, D_CONV)),
        "w_mh_norm": 1.0 + 0.02 * nrm(ks[14], (DEPTH, D_MLSTM)),
        "w_out": BETA * D_MODEL ** -0.5 * nrm(ks[15], (DEPTH, D_MODEL, D_MODEL)),
        "ln1_g": 1.0 + 0.02 * nrm(ks[16], (DEPTH, D_MODEL)),
        "ln1_b": 0.02 * nrm(ks[17], (DEPTH, D_MODEL)),
        "w_up": D_MODEL ** -0.5 * nrm(ks[18], (DEPTH, D_MODEL, 2 * D_FF)),
        "w_ffn_conv": CONV_K ** -0.5 * nrm(ks[19], (DEPTH, CONV_K, D_FF)),
        "w_down": BETA * D_FF ** -0.5 * nrm(ks[20], (DEPTH, D_FF, D_MODEL)),
        "ln2_g": 1.0 + 0.02 * nrm(ks[21], (DEPTH, D_MODEL)),
        "ln2_b": 0.02 * nrm(ks[22], (DEPTH, D_MODEL)),
    }


def reference(x_prompt, x_sample, c_prompt, c_sample, state_conv, state_mlstm_C, state_mlstm_n,
              state_mlstm_m, state_ffn_conv, w_ada, b_ada, w_in, b_gate, w_conv, w_mh_norm, w_out,
              ln1_g, ln1_b, w_up, w_ffn_conv, w_down, ln2_g, ln2_b):
    Bp = x_prompt.shape[0]
    f32 = jnp.float32
    xp = x_prompt
    xs = x_sample
    pc, pC, pn, pm, pf = [], [], [], [], []
    sc, sC, sn, sm, sf = [], [], [], [], []
    for l in range(DEPTH):
        wl = (w_ada[l], b_ada[l], w_in[l], b_gate[l], w_conv[l], w_mh_norm[l], w_out[l],
              ln1_g[l], ln1_b[l], w_up[l], w_ffn_conv[l], w_down[l], ln2_g[l], ln2_b[l])
        xp, c1, C1, n1, m1, f1 = _layer(
            xp, c_prompt,
            jnp.zeros((Bp, CONV_K - 1, D_CONV), f32),
            jnp.zeros((Bp, N_HEADS, HEAD_DIM, HEAD_DIM), f32),
            jnp.zeros((Bp, N_HEADS, HEAD_DIM), f32),
            jnp.zeros((Bp, N_HEADS), f32),
            jnp.zeros((Bp, CONV_K - 1, D_FF), f32), *wl)
        pc.append(c1); pC.append(C1); pn.append(n1); pm.append(m1); pf.append(f1)
        xs, c2, C2, n2, m2, f2 = _layer(
            xs, c_sample, state_conv[l], state_mlstm_C[l], state_mlstm_n[l], state_mlstm_m[l],
            state_ffn_conv[l], *wl)
        sc.append(c2); sC.append(C2); sn.append(n2); sm.append(m2); sf.append(f2)
    y_prompt = xp.astype(x_prompt.dtype)
    y_sample = xs.astype(x_sample.dtype)
    return (y_prompt, y_sample,
            jnp.stack(pc), jnp.stack(pC), jnp.stack(pn), jnp.stack(pm), jnp.stack(pf),
            jnp.stack(sc), jnp.stack(sC), jnp.stack(sn), jnp.stack(sm), jnp.stack(sf))
```

```cpp
#include <hip/hip_runtime.h>
#include <hip/hip_cooperative_groups.h>
#include <cstdio>
namespace cg = cooperative_groups;

#ifndef DUPMASK
#define DUPMASK 0
#endif
#ifndef MK_MULTI
#define MK_MULTI 0
#endif

#define DI __device__ __forceinline__
typedef unsigned short bf16_t;
typedef short bf16x8 __attribute__((ext_vector_type(8)));
typedef float f32x4 __attribute__((ext_vector_type(4)));
typedef float f32x16 __attribute__((ext_vector_type(16)));
typedef unsigned u32x4 __attribute__((ext_vector_type(4)));
typedef unsigned u32x2 __attribute__((ext_vector_type(2)));

constexpr int D = 2048, MP = 8192, MS = 512, M = 8704;
constexpr int NP = 7168, INC = 7176, DFF = 5632, NUP = 11264;
constexpr float LN_EPS = 1e-5f;
constexpr float ALPHA = 1.189207115002721f;

constexpr size_t OFF_WT_IN = 0;
constexpr size_t OFF_WT_OUT = OFF_WT_IN + (size_t)NP * D * 2;
constexpr size_t OFF_WT_UP = OFF_WT_OUT + (size_t)D * D * 2;
constexpr size_t OFF_U = OFF_WT_UP + (size_t)NUP * D * 2;
constexpr size_t OFF_HMID = 0;
constexpr size_t OFF_WT_DOWN = OFF_U + (size_t)M * D * 2;
constexpr size_t OFF_MOD = OFF_WT_DOWN + (size_t)D * DFF * 2;
constexpr size_t OFF_LG = OFF_MOD + (size_t)132 * 12288 * 4;
constexpr size_t OFF_CTL = OFF_LG + (size_t)M * 8 * 4;
constexpr size_t CTL_BYTES = 4096 + 16384;
constexpr size_t OFF_MIX = OFF_CTL + CTL_BYTES;
constexpr size_t OFF_X1 = OFF_MIX + (size_t)M * D * 4;
constexpr size_t OFF_E = OFF_X1 + (size_t)M * D * 4;
constexpr size_t OFF_P = OFF_E;
constexpr size_t OFF_MIXIN = OFF_P + (size_t)M * NP * 2;
constexpr size_t OFF_HRAW = OFF_MIXIN + (size_t)M * D * 2;
constexpr size_t OFF_UP = OFF_E;
constexpr size_t OFF_PART_OUT = OFF_P;
constexpr size_t OFF_PART_DOWN = OFF_E;
constexpr size_t WS_END = OFF_E + (size_t)M * NUP * 2;
static_assert((size_t)M * DFF * 2 <= OFF_WT_DOWN, "HMID alias");
static_assert(OFF_HRAW + (size_t)M * 1024 * 2 <= WS_END, "region E");

constexpr size_t O_YS = 16777216, O_PCONV = 17825792, O_PC = 17833984, O_PN = 18882560, O_PM = 18886656, O_PFFN = 18886672,
                 O_SCONV = 18931728, O_SC = 19193872, O_SN = 52748304, O_SM = 52879376, O_SFFN = 52879888;

constexpr int LDS_BYTES = 147456;
constexpr int LDS_SLOT = LDS_BYTES - 64;

struct Params { const float* in[23]; float* out; unsigned char* ws; int ph_lo, ph_hi; };

typedef __bf16 bf16v2_t __attribute__((ext_vector_type(2)));
typedef float f32x2_t __attribute__((ext_vector_type(2)));
DI unsigned cvt_pk_bf16(float lo, float hi) { const f32x2_t v = {lo, hi}; return __builtin_bit_cast(unsigned, __builtin_convertvector(v, bf16v2_t)); }
DI float bf_lo(unsigned u) { return __uint_as_float(u << 16); }
DI float bf_hi(unsigned u) { return __uint_as_float(u & 0xffff0000u); }
DI float bf2f(bf16_t v) { return __uint_as_float(((unsigned)v) << 16); }
DI bf16_t f2bf(float f) { return (bf16_t)(cvt_pk_bf16(f, 0.f) & 0xffffu); }
DI float wave_sum(float v) {
#pragma unroll
    for (int o = 32; o > 0; o >>= 1) v += __shfl_xor(v, o);
    return v;
}
DI float sigmoidf_(float x) { return 1.0f / (1.0f + __expf(-x)); }
DI float siluf_(float x) { return x / (1.0f + __expf(-x)); }
DI int crow(int r, int h) { return (r & 3) + 8 * (r >> 2) + 4 * h; }
DI int tidx() { int t = threadIdx.x; asm volatile("" : "+v"(t)); return t; }
DI void unpack8(const u32x4 v, float* f) {
    f[0] = bf_lo(v.x); f[1] = bf_hi(v.x); f[2] = bf_lo(v.y); f[3] = bf_hi(v.y);
    f[4] = bf_lo(v.z); f[5] = bf_hi(v.z); f[6] = bf_lo(v.w); f[7] = bf_hi(v.w);
}
DI u32x4 pack8(const float* f) {
    u32x4 r; r.x = cvt_pk_bf16(f[0], f[1]); r.y = cvt_pk_bf16(f[2], f[3]); r.z = cvt_pk_bf16(f[4], f[5]); r.w = cvt_pk_bf16(f[6], f[7]); return r;
}
#define MFMA32(a, b, c) __builtin_amdgcn_mfma_f32_32x32x16_bf16((a), (b), (c), 0, 0, 0)

DI int next_item(unsigned* ctr, unsigned char* lds) {
    volatile int* slot = (volatile int*)(lds + LDS_SLOT);
    __syncthreads();
    if (threadIdx.x == 0) *slot = (int)atomicAdd(ctr, 1u);
    __syncthreads();
    return *slot;
}

namespace pg8 {
#define PG8_LAS __attribute__((address_space(3)))
constexpr int BM = 256, BK = 64, HALF = 128, HTB = HALF * BK * 2, STAGE_BYTES = 8 * HTB, NXCD = 8, WGM = 8;
DI int lds_byte(int r, int c) { const int st = (r >> 4) * 2 + (c >> 5), rr = r & 15, cc = c & 31, ob = rr * 64 + cc * 2; return st * 1024 + (ob ^ (((ob >> 9) & 1) << 5)); }
DI void stage_rc(int b, int& R, int& C) { const int st = b / 1024, sb = b % 1024, swz = sb ^ (((sb >> 9) & 1) << 5); R = (st >> 1) * 16 + swz / 64; C = (st & 1) * 32 + (swz % 64) / 2; }
DI int perm32(int rho) { const int n = rho >> 4, i = rho & 15; return 8 * (i >> 2) + 4 * n + (i & 3); }
struct Unit { int pm, pn, ks, ko; };
struct Gemm { const bf16_t* A; const bf16_t* Bt; int M, N, K, lda, ldb; };
struct StaticOrder {
    int nM, nN, nwg, G, c;
    DI void init(int M_, int N_, int G_, int c_) { nM = M_ / BM; nN = N_ / BM; nwg = nM * nN; G = G_; c = c_; }
    DI bool next(int i, Unit& u) const {
        const long L = (long)i * G + c; if (L >= nwg) return false;
        int wgid = (int)L; { const int q = nwg / NXCD, r = nwg % NXCD, xcd = wgid % NXCD, off = wgid / NXCD; wgid = (xcd < r ? xcd * (q + 1) : r * (q + 1) + (xcd - r) * q) + off; }
        const int nig = WGM * nN, gid = wgid / nig, fm = gid * WGM, gsz = (nM - fm) < WGM ? (nM - fm) : WGM;
        u.pm = fm + ((wgid % nig) % gsz); u.pn = (wgid % nig) / gsz; u.ks = 0; u.ko = 0; return true;
    }
    DI void a_ready(const Unit&) const {}
    DI void done(const Unit&) const {}
};
struct SplitOrder {
    int nunits, G, c, kslice;
    DI void init(int S_, int kslice_, int G_, int c_) { nunits = 16 * S_; kslice = kslice_; G = G_; c = c_; }
    DI bool next(int i, Unit& u) const {
        const int L = i * G + c; if (L >= nunits) return false;
        u.pn = L & 7; u.pm = (L >> 3) & 1; u.ks = L >> 4; u.ko = u.ks * kslice; return true;
    }
    DI void a_ready(const Unit&) const {}
    DI void done(const Unit&) const {}
};
struct EpiF32 {
    static constexpr bool PERM = false;
    float* C; int ldc; size_t split_stride;
    DI void operator()(const f32x4 (&acc)[2][2][4][2], const Unit& u, int wr, int wc, int fr, int fq) const {
        const int row0 = u.pm * BM + wr * 64 + fr, col0 = u.pn * BM + wc * 32 + 4 * fq;
        float* const Cb = C + (size_t)u.ks * split_stride;
#pragma unroll
        for (int ai = 0; ai < 2; ++ai)
#pragma unroll
            for (int m = 0; m < 4; ++m) { float* rowp = Cb + (size_t)(row0 + ai * HALF + m * 16) * ldc + col0;
#pragma unroll
                for (int bj = 0; bj < 2; ++bj)
#pragma unroll
                    for (int n = 0; n < 2; ++n) *(f32x4*)(rowp + bj * HALF + n * 16) = acc[ai][bj][m][n]; }
    }
};
struct EpiBf16 {
    static constexpr bool PERM = true;
    bf16_t* O; int ldc;
    DI void operator()(const f32x4 (&acc)[2][2][4][2], const Unit& u, int wr, int wc, int fr, int fq) const {
        const int row0 = u.pm * BM + wr * 64 + fr; const int col0 = u.pn * BM + wc * 32 + 8 * fq;
#pragma unroll
        for (int ai = 0; ai < 2; ++ai)
#pragma unroll
            for (int m = 0; m < 4; ++m) { bf16_t* rowp = O + (size_t)(row0 + ai * HALF + m * 16) * ldc + col0;
#pragma unroll
                for (int bj = 0; bj < 2; ++bj) { const f32x4 v0 = acc[ai][bj][m][0], v1 = acc[ai][bj][m][1];
                    u32x4 w; w.x = cvt_pk_bf16(v0[0], v0[1]); w.y = cvt_pk_bf16(v0[2], v0[3]); w.z = cvt_pk_bf16(v1[0], v1[1]); w.w = cvt_pk_bf16(v1[2], v1[3]);
                    *(u32x4*)(rowp + bj * HALF) = w; } }
    }
};

template <class Epi, class Sched>
DI void gemm_phase(PG8_LAS unsigned char* lds, const Gemm g, const Sched& S, const Epi& E) {
    const int tid = tidx(), wid = __builtin_amdgcn_readfirstlane(tid >> 6), lane = tid & 63, wr = wid >> 2, wc = wid & 3, fr = lane & 15, fq = lane >> 4;
    const int K = g.K, nt = K / BK;
    unsigned voffA[2], voffB[2];
#pragma unroll
    for (int i = 0; i < 2; ++i) { int R, C; stage_rc(tid * 16 + i * 8192, R, C); const int Rb = Epi::PERM ? ((R & ~31) + perm32(R & 31)) : R;
        voffA[i] = (unsigned)(R * g.lda + C) * 2u; voffB[i] = (unsigned)(Rb * g.ldb + C) * 2u; }
    const size_t kstep = (size_t)(BK * 2);
    const size_t hstepA = (size_t)HALF * g.lda * 2, hstepB = (size_t)HALF * g.ldb * 2;
    const size_t tstepA = 2 * hstepA, tstepB = 2 * hstepB;
    const unsigned ldsw = (unsigned)wid * 1024u;
    const int aoff = lds_byte(wr * 64 + fr, fq * 8), boff = lds_byte(wc * 32 + fr, fq * 8);
#define PG8_SA(b, h) (((b) * 2 + (h)) * HTB)
#define PG8_SB(b, h) ((4 + (b) * 2 + (h)) * HTB)
#define PG8_STAGE(bufoff, gbase, voff) do { _Pragma("unroll") for (int _i = 0; _i < 2; ++_i) \
        __builtin_amdgcn_global_load_lds((const unsigned*)((const char*)(gbase) + (voff)[_i]), (PG8_LAS unsigned*)(lds + (bufoff) + ldsw + _i * 8192), 16, 0, 0); } while (0)
#define PG8_LDA(dst, b, h) do { _Pragma("unroll") for (int m = 0; m < 4; ++m) _Pragma("unroll") for (int k = 0; k < 2; ++k) dst[m][k] = *(const PG8_LAS bf16x8*)(lds + PG8_SA(b, h) + aoff + m * 2048 + k * 1024); } while (0)
#define PG8_LDB(dst, b, h) do { _Pragma("unroll") for (int n = 0; n < 2; ++n) _Pragma("unroll") for (int k = 0; k < 2; ++k) dst[n][k] = *(const PG8_LAS bf16x8*)(lds + PG8_SB(b, h) + boff + n * 2048 + k * 1024); } while (0)
#define PG8_MMA(ai, bj, At, Bt) do { __builtin_amdgcn_s_setprio(1); _Pragma("unroll") for (int m = 0; m < 4; ++m) _Pragma("unroll") for (int n = 0; n < 2; ++n) _Pragma("unroll") for (int k = 0; k < 2; ++k) \
        acc[ai][bj][m][n] = __builtin_amdgcn_mfma_f32_16x16x32_bf16(Bt[n][k], At[m][k], acc[ai][bj][m][n], 0, 0, 0); __builtin_amdgcn_s_setprio(0); } while (0)
#define PG8_WAIT_V(n) asm volatile("s_waitcnt vmcnt(" #n ")" ::: "memory")
#define PG8_WAIT_L(n) asm volatile("s_waitcnt lgkmcnt(" #n ")" ::: "memory")
#define PG8_BAR __builtin_amdgcn_s_barrier()
#define PG8_SCHED __builtin_amdgcn_sched_barrier(0)
    Unit cur, nxt; int ui = 0;
    if (!S.next(0, cur)) return;
    f32x4 acc[2][2][4][2];
#pragma unroll
    for (int a = 0; a < 2; ++a)
#pragma unroll
        for (int b = 0; b < 2; ++b)
#pragma unroll
            for (int m = 0; m < 4; ++m)
#pragma unroll
                for (int n = 0; n < 2; ++n) acc[a][b][m][n] = (f32x4){0.f, 0.f, 0.f, 0.f};
    bf16x8 At[4][2], B0[2][2], B1[2][2];
    const char* cA = (const char*)g.A + (size_t)cur.pm * tstepA + (size_t)cur.ko * 2; const char* cB = (const char*)g.Bt + (size_t)cur.pn * tstepB + (size_t)cur.ko * 2;
    S.a_ready(cur);
    PG8_STAGE(PG8_SB(0, 0), cB, voffB); PG8_STAGE(PG8_SA(0, 0), cA, voffA); PG8_STAGE(PG8_SB(0, 1), cB + hstepB, voffB); PG8_STAGE(PG8_SA(0, 1), cA + hstepA, voffA);
    if (wr == 1) PG8_BAR;
    PG8_WAIT_V(4); PG8_BAR;
    PG8_STAGE(PG8_SB(1, 0), cB + kstep, voffB); PG8_STAGE(PG8_SA(1, 0), cA + kstep, voffA); PG8_STAGE(PG8_SB(1, 1), cB + hstepB + kstep, voffB);
    PG8_WAIT_V(6); PG8_BAR;
    for (;;) {
        const bool has_next = S.next(ui + 1, nxt);
        const char* nA = has_next ? (const char*)g.A + (size_t)nxt.pm * tstepA + (size_t)nxt.ko * 2 : cA; const char* nB = has_next ? (const char*)g.Bt + (size_t)nxt.pn * tstepB + (size_t)nxt.ko * 2 : cB;
        for (int t = 0; t < nt; t += 2) {
            const bool last = (t == nt - 2);
            const char* a1 = cA + (size_t)(t + 1) * kstep;
            const char* a2 = last ? nA : cA + (size_t)(t + 2) * kstep; const char* b2 = last ? nB : cB + (size_t)(t + 2) * kstep;
            const char* a3 = a2 + kstep; const char* b3 = b2 + kstep;
            if (last && has_next) S.a_ready(nxt);
            PG8_LDB(B0, 0, 0); PG8_SCHED; PG8_LDA(At, 0, 0); PG8_STAGE(PG8_SA(1, 1), a1 + hstepA, voffA);
            PG8_WAIT_L(8); PG8_BAR; PG8_WAIT_L(0); PG8_MMA(0, 0, At, B0); PG8_BAR; PG8_SCHED;
            PG8_LDB(B1, 0, 1); PG8_STAGE(PG8_SB(0, 0), b2, voffB);
            PG8_BAR; PG8_WAIT_L(0); PG8_MMA(0, 1, At, B1); PG8_BAR;
            PG8_LDA(At, 0, 1); PG8_STAGE(PG8_SA(0, 0), a2, voffA);
            PG8_BAR; PG8_WAIT_L(0); PG8_MMA(1, 0, At, B0); PG8_BAR; PG8_SCHED;
            PG8_STAGE(PG8_SB(0, 1), b2 + hstepB, voffB);
            PG8_WAIT_V(6); PG8_BAR; PG8_MMA(1, 1, At, B1); PG8_BAR;
            PG8_LDB(B0, 1, 0); PG8_SCHED; PG8_LDA(At, 1, 0); PG8_STAGE(PG8_SA(0, 1), a2 + hstepA, voffA);
            PG8_WAIT_L(8); PG8_BAR; PG8_WAIT_L(0); PG8_MMA(0, 0, At, B0); PG8_BAR; PG8_SCHED;
            PG8_LDB(B1, 1, 1); PG8_STAGE(PG8_SB(1, 0), b3, voffB);
            PG8_BAR; PG8_WAIT_L(0); PG8_MMA(0, 1, At, B1); PG8_BAR;
            PG8_LDA(At, 1, 1); PG8_STAGE(PG8_SA(1, 0), a3, voffA);
            PG8_BAR; PG8_WAIT_L(0); PG8_MMA(1, 0, At, B0); PG8_BAR; PG8_SCHED;
            PG8_STAGE(PG8_SB(1, 1), b3 + hstepB, voffB);
            PG8_WAIT_V(6); PG8_BAR; PG8_MMA(1, 1, At, B1); PG8_BAR;
        }
        E(acc, cur, wr, wc, fr, fq); S.done(cur);
        if (!has_next) break;
#pragma unroll
        for (int a = 0; a < 2; ++a)
#pragma unroll
            for (int b = 0; b < 2; ++b)
#pragma unroll
                for (int m = 0; m < 4; ++m)
#pragma unroll
                    for (int n = 0; n < 2; ++n) acc[a][b][m][n] = (f32x4){0.f, 0.f, 0.f, 0.f};
        cur = nxt; cA = nA; cB = nB; ++ui;
    }
    PG8_WAIT_V(0);
    if (wr == 0) PG8_BAR;
    PG8_BAR;
#undef PG8_SA
#undef PG8_SB
#undef PG8_STAGE
#undef PG8_LDA
#undef PG8_LDB
#undef PG8_MMA
#undef PG8_WAIT_V
#undef PG8_WAIT_L
#undef PG8_BAR
#undef PG8_SCHED
}
}

DI void transpose_item(const float* __restrict__ src, int ldn, bf16_t* __restrict__ dst, int K, int n0, int k0, unsigned char* lds) {
    const int t = tidx();
    unsigned* T = (unsigned*)lds;
    float4 va[4], vb[4];
#pragma unroll
    for (int i = 0; i < 4; ++i) { const int idx = t + 512 * i, n4 = idx & 15, kp = idx >> 4;
        const float* p = src + (size_t)(k0 + 2 * kp) * ldn + n0 + 4 * n4;
        va[i] = *(const float4*)p; vb[i] = *(const float4*)(p + ldn); }
#pragma unroll
    for (int i = 0; i < 4; ++i) { const int idx = t + 512 * i, n4 = idx & 15, kp = idx >> 4;
        T[(4 * n4 + 0) * 130 + kp] = cvt_pk_bf16(va[i].x, vb[i].x);
        T[(4 * n4 + 1) * 130 + kp] = cvt_pk_bf16(va[i].y, vb[i].y);
        T[(4 * n4 + 2) * 130 + kp] = cvt_pk_bf16(va[i].z, vb[i].z);
        T[(4 * n4 + 3) * 130 + kp] = cvt_pk_bf16(va[i].w, vb[i].w); }
    __syncthreads();
#pragma unroll
    for (int i = 0; i < 8; ++i) { const int idx = t + 512 * i, n = idx >> 6, k4 = idx & 63;
        const u32x2 v = *(const u32x2*)(lds + n * 520 + k4 * 8);
        *(u32x2*)(dst + (size_t)(n0 + n) * K + k0 + 4 * k4) = v; }
    __syncthreads();
}

DI void ada_item(const Params& p, int slab, unsigned char* lds) {
    const int t = tidx(), lane = t & 63, w = __builtin_amdgcn_readfirstlane(t >> 6);
    bf16_t* As = (bf16_t*)lds;
    bf16_t* Bs = (bf16_t*)(lds + 160 * 144);
    const int n0 = slab * 64;
    const float* wa = p.in[9];
    const float* cp = p.in[2]; const float* cs = p.in[3];
    float* MOD = (float*)(p.ws + OFF_MOD);
    f32x16 acc0, acc1;
#pragma unroll
    for (int r = 0; r < 16; ++r) { acc0[r] = 0.f; acc1[r] = 0.f; }
    const int mt0 = w % 5, nt0 = w / 5, mt1 = (w + 8) % 5, nt1 = (w + 8) / 5;
    float4 ca[5], wb[2];
#pragma unroll
    for (int i = 0; i < 5; ++i) { const int idx = t + 512 * i, m = idx >> 4, k4 = idx & 15;
        const float* cr = m < 4 ? cp + (size_t)m * D : cs + (size_t)(m - 4) * D;
        ca[i] = m < 132 ? *(const float4*)(cr + 4 * k4) : make_float4(0.f, 0.f, 0.f, 0.f); }
#pragma unroll
    for (int i = 0; i < 2; ++i) { const int idx = t + 512 * i, k = idx >> 4, n4 = idx & 15;
        wb[i] = *(const float4*)(wa + (size_t)k * 12288 + n0 + 4 * n4); }
    for (int kc = 0; kc < 32; ++kc) {
#pragma unroll
        for (int i = 0; i < 5; ++i) { const int idx = t + 512 * i, m = idx >> 4, k4 = idx & 15;
            u32x2 v; v.x = cvt_pk_bf16(siluf_(ca[i].x), siluf_(ca[i].y)); v.y = cvt_pk_bf16(siluf_(ca[i].z), siluf_(ca[i].w));
            *(u32x2*)(As + m * 72 + 4 * k4) = v; }
#pragma unroll
        for (int i = 0; i < 2; ++i) { const int idx = t + 512 * i, k = idx >> 4, n4 = idx & 15;
            Bs[(4 * n4 + 0) * 72 + k] = f2bf(wb[i].x); Bs[(4 * n4 + 1) * 72 + k] = f2bf(wb[i].y);
            Bs[(4 * n4 + 2) * 72 + k] = f2bf(wb[i].z); Bs[(4 * n4 + 3) * 72 + k] = f2bf(wb[i].w); }
        __syncthreads();
        if (kc + 1 < 32) {
            const int kb = (kc + 1) * 64;
#pragma unroll
            for (int i = 0; i < 5; ++i) { const int idx = t + 512 * i, m = idx >> 4, k4 = idx & 15;
                const float* cr = m < 4 ? cp + (size_t)m * D : cs + (size_t)(m - 4) * D;
                ca[i] = m < 132 ? *(const float4*)(cr + kb + 4 * k4) : make_float4(0.f, 0.f, 0.f, 0.f); }
#pragma unroll
            for (int i = 0; i < 2; ++i) { const int idx = t + 512 * i, k = idx >> 4, n4 = idx & 15;
                wb[i] = *(const float4*)(wa + (size_t)(kb + k) * 12288 + n0 + 4 * n4); }
        }
#pragma unroll
        for (int ks = 0; ks < 4; ++ks) {
            const int ko = ks * 16 + 8 * (lane >> 5);
            const bf16x8 a0 = *(const bf16x8*)(As + (mt0 * 32 + (lane & 31)) * 72 + ko);
            const bf16x8 b0 = *(const bf16x8*)(Bs + (nt0 * 32 + (lane & 31)) * 72 + ko);
            acc0 = MFMA32(a0, b0, acc0);
            if (w < 2) {
                const bf16x8 a1 = *(const bf16x8*)(As + (mt1 * 32 + (lane & 31)) * 72 + ko);
                const bf16x8 b1 = *(const bf16x8*)(Bs + (nt1 * 32 + (lane & 31)) * 72 + ko);
                acc1 = MFMA32(a1, b1, acc1);
            }
        }
        __syncthreads();
    }
    const float* ba = p.in[10];
    {
        const int n = n0 + nt0 * 32 + (lane & 31); const float bv = ba[n];
#pragma unroll
        for (int r = 0; r < 16; ++r) { const int m = mt0 * 32 + crow(r, lane >> 5); if (m < 132) MOD[(size_t)m * 12288 + n] = acc0[r] + bv; }
    }
    if (w < 2) {
        const int n = n0 + nt1 * 32 + (lane & 31); const float bv = ba[n];
#pragma unroll
        for (int r = 0; r < 16; ++r) { const int m = mt1 * 32 + crow(r, lane >> 5); if (m < 132) MOD[(size_t)m * 12288 + n] = acc1[r] + bv; }
    }
}

DI void tr_w_in(const Params& p, int it, unsigned char* lds) { transpose_item(p.in[11], INC, (bf16_t*)(p.ws + OFF_WT_IN), D, (it >> 3) * 64, (it & 7) * 256, lds); }
DI void tr_w_out(const Params& p, int it, unsigned char* lds) { transpose_item(p.in[15], D, (bf16_t*)(p.ws + OFF_WT_OUT), D, (it >> 3) * 64, (it & 7) * 256, lds); }
DI void tr_w_up(const Params& p, int it, unsigned char* lds) { transpose_item(p.in[18], NUP, (bf16_t*)(p.ws + OFF_WT_UP), D, (it >> 3) * 64, (it & 7) * 256, lds); }
DI void tr_w_down(const Params& p, int it, unsigned char* lds) { transpose_item(p.in[20], D, (bf16_t*)(p.ws + OFF_WT_DOWN), DFF, (it / 22) * 64, (it % 22) * 256, lds); }
DI void phase0(const Params& p, unsigned char* lds, int ctr_off) {
    unsigned* ctr = (unsigned*)(p.ws + OFF_CTL) + ctr_off;
    for (;;) {
        int it = next_item(ctr, lds);
        if (it >= 192 + 896 + 256 + 704) break;
        if (it < 192) { ada_item(p, it, lds); continue; }
        it -= 192;
        if (it < 896) { tr_w_in(p, it, lds); continue; }
        it -= 896;
        if (it < 256) { tr_w_out(p, it, lds); continue; }
        it -= 256;
        tr_w_up(p, it, lds);
    }
}
DI void phase2_idle(const Params& p, unsigned char* lds, int ctr_off) {
    unsigned* ctr = (unsigned*)(p.ws + OFF_CTL) + ctr_off;
    for (;;) { const int it = next_item(ctr, lds); if (it >= 704) break; tr_w_down(p, it, lds); }
}

DI int mod_row(int row) { return row < MP ? (row >> 11) : 4 + ((row - MP) >> 2); }
DI void phase1(const Params& p, unsigned char* lds) {
    const int t = tidx(), lane = t & 63, w = t >> 6;
    float* wg = (float*)lds;
    const float* w_in = p.in[11];
#pragma unroll
    for (int i = 0; i < 8; ++i) { const int idx = t + 512 * i, c = idx >> 1, hf = idx & 1;
        const float4 v = *(const float4*)(w_in + (size_t)c * INC + NP + 4 * hf);
        wg[(4 * hf + 0) * 2048 + c] = v.x; wg[(4 * hf + 1) * 2048 + c] = v.y; wg[(4 * hf + 2) * 2048 + c] = v.z; wg[(4 * hf + 3) * 2048 + c] = v.w; }
    __syncthreads();
    const float* bgate = p.in[12];
    const float* MOD = (const float*)(p.ws + OFF_MOD);
    bf16_t* U = (bf16_t*)(p.ws + OFF_U);
    float* LG = (float*)(p.ws + OFF_LG);
    for (int row = blockIdx.x * 8 + w; row < M; row += gridDim.x * 8) {
        const float* xr = row < MP ? p.in[0] + (size_t)row * D : p.in[1] + (size_t)(row - MP) * D;
        const float* mod = MOD + (size_t)mod_row(row) * 12288;
        float4 xv[8];
        float s = 0.f;
#pragma unroll
        for (int i = 0; i < 8; ++i) { xv[i] = *(const float4*)(xr + (i * 64 + lane) * 4); s += (xv[i].x + xv[i].y) + (xv[i].z + xv[i].w); }
        const float mu = wave_sum(s) * (1.0f / 2048.0f);
        float q = 0.f;
#pragma unroll
        for (int i = 0; i < 8; ++i) { const float a = xv[i].x - mu, b = xv[i].y - mu, c = xv[i].z - mu, d = xv[i].w - mu; q += (a * a + b * b) + (c * c + d * d); }
        const float rstd = rsqrtf(wave_sum(q) * (1.0f / 2048.0f) + LN_EPS);
        float g[8];
#pragma unroll
        for (int j = 0; j < 8; ++j) g[j] = 0.f;
#pragma unroll
        for (int i = 0; i < 8; ++i) {
            const int c = (i * 64 + lane) * 4;
            const float4 sh = *(const float4*)(mod + c), sc = *(const float4*)(mod + 2048 + c);
            float4 u;
            u.x = (xv[i].x - mu) * rstd * (1.0f + sc.x) + sh.x; u.y = (xv[i].y - mu) * rstd * (1.0f + sc.y) + sh.y;
            u.z = (xv[i].z - mu) * rstd * (1.0f + sc.z) + sh.z; u.w = (xv[i].w - mu) * rstd * (1.0f + sc.w) + sh.w;
            u32x2 o; o.x = cvt_pk_bf16(u.x, u.y); o.y = cvt_pk_bf16(u.z, u.w);
            *(u32x2*)(U + (size_t)row * D + c) = o;
#pragma unroll
            for (int j = 0; j < 8; ++j) { const float4 wv = *(const float4*)(wg + j * 2048 + c); g[j] += (u.x * wv.x + u.y * wv.y) + (u.z * wv.z + u.w * wv.w); }
            __builtin_amdgcn_sched_barrier(0);
        }
#pragma unroll
        for (int j = 0; j < 8; ++j) g[j] = wave_sum(g[j]);
        float gj = g[0];
#pragma unroll
        for (int j = 1; j < 8; ++j) gj = (lane == j) ? g[j] : gj;
        if (lane < 8) {
            float val = gj + bgate[lane];
            if (lane >= 4) val = fminf(val, 0.f) - log1pf(__expf(-fabsf(val)));
            LG[(size_t)row * 8 + lane] = val;
        }
    }
}

DI void conv_item(const Params& p, int item) {
    const int t = tidx();
    const int c8 = (t & 127) * 8, rq = t >> 7;
    const bf16_t* P = (const bf16_t*)(p.ws + OFF_P);
    bf16_t* MIXIN = (bf16_t*)(p.ws + OFF_MIXIN);
    const float* wconv = p.in[13];
    float w0[8], w1[8], w2[8];
#pragma unroll
    for (int j = 0; j < 8; ++j) { w0[j] = wconv[c8 + j]; w1[j] = wconv[1024 + c8 + j]; w2[j] = wconv[2048 + c8 + j]; }
    if (item < 128) {
        const int row0 = item * 64 + rq * 16, tp0 = row0 & 2047;
        float zm2[8], zm1[8];
        if (tp0 == 0) {
#pragma unroll
            for (int e = 0; e < 8; ++e) { zm2[e] = 0.f; zm1[e] = 0.f; }
        } else {
            float a[8], h[8];
            const bf16_t* pr = P + (size_t)(row0 - 2) * NP;
            unpack8(*(const u32x4*)(pr + 1024 + c8), a); unpack8(*(const u32x4*)(pr + 2048 + c8), h);
#pragma unroll
            for (int e = 0; e < 8; ++e) zm2[e] = a[e] * h[e];
            unpack8(*(const u32x4*)(pr + NP + 1024 + c8), a); unpack8(*(const u32x4*)(pr + NP + 2048 + c8), h);
#pragma unroll
            for (int e = 0; e < 8; ++e) zm1[e] = a[e] * h[e];
        }
        for (int q = 0; q < 16; q += 4) {
            u32x4 av[4], hv[4], bv[4];
#pragma unroll
            for (int k = 0; k < 4; ++k) { const bf16_t* pr = P + (size_t)(row0 + q + k) * NP + c8; bv[k] = *(const u32x4*)pr; av[k] = *(const u32x4*)(pr + 1024); hv[k] = *(const u32x4*)(pr + 2048); }
#pragma unroll
            for (int k = 0; k < 4; ++k) {
                float a[8], h[8], bg[8], z[8], y[8];
                unpack8(av[k], a); unpack8(hv[k], h); unpack8(bv[k], bg);
#pragma unroll
                for (int e = 0; e < 8; ++e) { z[e] = a[e] * h[e]; y[e] = bg[e] * (w0[e] * zm2[e] + w1[e] * zm1[e] + w2[e] * z[e]); }
                *(u32x4*)(MIXIN + (size_t)(row0 + q + k) * D + c8) = pack8(y);
#pragma unroll
                for (int e = 0; e < 8; ++e) { zm2[e] = zm1[e]; zm1[e] = z[e]; }
            }
        }
        if (tp0 + 16 == 2048) {
            float* o = p.out + O_PCONV + (size_t)((row0 >> 11) * 2) * 1024 + c8;
            *(float4*)(o) = make_float4(zm2[0], zm2[1], zm2[2], zm2[3]); *(float4*)(o + 4) = make_float4(zm2[4], zm2[5], zm2[6], zm2[7]);
            *(float4*)(o + 1024) = make_float4(zm1[0], zm1[1], zm1[2], zm1[3]); *(float4*)(o + 1028) = make_float4(zm1[4], zm1[5], zm1[6], zm1[7]);
        }
        return;
    }
    for (int it = 0; it < 16; ++it) {
        const int rr = (item - 128) * 64 + it * 4 + rq, row = MP + rr;
        const int b = rr >> 2, tp = rr & 3;
        float z[3][8];
#pragma unroll
        for (int j = 0; j < 3; ++j) {
            const int tq = tp - 2 + j;
            if (tq >= 0) {
                const bf16_t* pr = P + (size_t)(row - 2 + j) * NP;
                float a[8], h[8];
                unpack8(*(const u32x4*)(pr + 1024 + c8), a); unpack8(*(const u32x4*)(pr + 2048 + c8), h);
#pragma unroll
                for (int e = 0; e < 8; ++e) z[j][e] = a[e] * h[e];
            } else {
                const float* sp = p.in[4] + (size_t)(b * 2 + tq + 2) * 1024 + c8;
                const float4 s0 = *(const float4*)sp, s1 = *(const float4*)(sp + 4);
                z[j][0] = s0.x; z[j][1] = s0.y; z[j][2] = s0.z; z[j][3] = s0.w; z[j][4] = s1.x; z[j][5] = s1.y; z[j][6] = s1.z; z[j][7] = s1.w;
            }
        }
        float bgv[8], y[8];
        unpack8(*(const u32x4*)(P + (size_t)row * NP + c8), bgv);
#pragma unroll
        for (int e = 0; e < 8; ++e) y[e] = bgv[e] * (w0[e] * z[0][e] + w1[e] * z[1][e] + w2[e] * z[2][e]);
        *(u32x4*)(MIXIN + (size_t)row * D + c8) = pack8(y);
        if (tp == 3) {
            float* o = p.out + O_SCONV + (size_t)(b * 2) * 1024 + c8;
            *(float4*)(o) = make_float4(z[1][0], z[1][1], z[1][2], z[1][3]); *(float4*)(o + 4) = make_float4(z[1][4], z[1][5], z[1][6], z[1][7]);
            *(float4*)(o + 1024) = make_float4(z[2][0], z[2][1], z[2][2], z[2][3]); *(float4*)(o + 1028) = make_float4(z[2][4], z[2][5], z[2][6], z[2][7]);
        }
    }
}

DI void mlstm_sample_item(const Params& p, int bh, unsigned char* lds) {
    const int t = tidx(), lane = t & 63, w = t >> 6;
    const int b = bh >> 2, hh = bh & 3, r0 = MP + b * 4;
    const bf16_t* P = (const bf16_t*)(p.ws + OFF_P);
    const float* LG = (const float*)(p.ws + OFF_LG);
    bf16_t* HRAW = (bf16_t*)(p.ws + OFF_HRAW);
    float* qS = (float*)lds; float* kS = qS + 1024; float* vS = kS + 1024; float* kwS = vS + 1024; float* nS = kwS + 1024;
    float* sc = nS + 256; float* dots = sc + 64; float* part = dots + 32;
#pragma unroll
    for (int i = 0; i < 6; ++i) { const int idx = t + 512 * i, arr = idx >> 10, rem = idx & 1023, tt = rem >> 8, d = rem & 255;
        float v = bf2f(P[(size_t)(r0 + tt) * NP + 3072 + arr * 1024 + hh * 256 + d]);
        if (arr == 1) v *= 0.0625f;
        qS[idx] = v; }
    if (t < 256) nS[t] = p.in[6][(size_t)bh * 256 + t];
    if (t == 0) {
        float li[4], lf[4], bb[4], aa[4], mt[4];
        const float m0 = p.in[7][bh];
#pragma unroll
        for (int i = 0; i < 4; ++i) { li[i] = LG[(size_t)(r0 + i) * 8 + hh]; lf[i] = LG[(size_t)(r0 + i) * 8 + 4 + hh]; }
        bb[0] = lf[0]; bb[1] = bb[0] + lf[1]; bb[2] = bb[1] + lf[2]; bb[3] = bb[2] + lf[3];
#pragma unroll
        for (int i = 0; i < 4; ++i) {
            aa[i] = bb[i] + m0; float m = aa[i];
#pragma unroll
            for (int s = 0; s < 4; ++s) if (s <= i) m = fmaxf(m, bb[i] - bb[s] + li[s]);
            mt[i] = m;
            sc[i] = __expf(aa[i] - m); sc[4 + i] = __expf(-m);
#pragma unroll
            for (int s = 0; s < 4; ++s) sc[16 + i * 4 + s] = (s <= i) ? __expf(bb[i] - bb[s] + li[s] - m) : 0.f;
        }
#pragma unroll
        for (int s = 0; s < 4; ++s) sc[8 + s] = __expf(bb[3] - bb[s] + li[s] - mt[3]);
        sc[12] = __expf(aa[3] - mt[3]); sc[13] = mt[3];
    }
    __syncthreads();
#pragma unroll
    for (int i = 0; i < 3; ++i) { const int pd = w + 8 * i;
        if (pd < 20) {
            const float* qa = qS + (pd < 16 ? (pd >> 2) : (pd - 16)) * 256 + lane * 4;
            const float* kb = (pd < 16 ? kS + (pd & 3) * 256 : nS) + lane * 4;
            const float4 x = *(const float4*)qa, y = *(const float4*)kb;
            const float sum = wave_sum((x.x * y.x + x.y * y.y) + (x.z * y.z + x.w * y.w));
            if (lane == 0) dots[pd] = sum;
        } }
#pragma unroll
    for (int i = 0; i < 2; ++i) { const int idx = t + 512 * i; kwS[idx] = sc[8 + (idx >> 8)] * kS[idx]; }
    __syncthreads();
    if (t < 4) {
        float den = 0.f;
#pragma unroll
        for (int s = 0; s < 4; ++s) { const float sp = dots[t * 4 + s] * sc[16 + t * 4 + s]; sc[32 + t * 4 + s] = sp; den += sp; }
        den += sc[t] * dots[16 + t];
        sc[48 + t] = fmaxf(fabsf(den), sc[4 + t]);
    }
    {
        const int e4 = lane, dg = w;
        const float dc = sc[12];
        float4 vv[4];
#pragma unroll
        for (int s = 0; s < 4; ++s) vv[s] = *(const float4*)(vS + s * 256 + 4 * e4);
        float4 acc[4];
#pragma unroll
        for (int tt = 0; tt < 4; ++tt) acc[tt] = make_float4(0.f, 0.f, 0.f, 0.f);
        const float* C0 = p.in[5] + (size_t)bh * 65536 + 4 * e4;
        float* C1 = p.out + O_SC + (size_t)bh * 65536 + 4 * e4;
        for (int i0 = 0; i0 < 32; i0 += 8) {
            float4 cv[8];
#pragma unroll
            for (int u = 0; u < 8; ++u) cv[u] = *(const float4*)(C0 + (size_t)(dg + 8 * (i0 + u)) * 256);
#pragma unroll
            for (int u = 0; u < 8; ++u) {
                const int d = dg + 8 * (i0 + u);
                const float4 c = cv[u];
                float4 cn = make_float4(dc * c.x, dc * c.y, dc * c.z, dc * c.w);
#pragma unroll
                for (int tt = 0; tt < 4; ++tt) { const float qv = qS[tt * 256 + d];
                    acc[tt].x += qv * c.x; acc[tt].y += qv * c.y; acc[tt].z += qv * c.z; acc[tt].w += qv * c.w; }
#pragma unroll
                for (int s = 0; s < 4; ++s) { const float kv = kwS[s * 256 + d];
                    cn.x += kv * vv[s].x; cn.y += kv * vv[s].y; cn.z += kv * vv[s].z; cn.w += kv * vv[s].w; }
                *(float4*)(C1 + (size_t)d * 256) = cn;
            }
        }
#pragma unroll
        for (int tt = 0; tt < 4; ++tt) *(float4*)(part + (dg * 4 + tt) * 256 + 4 * e4) = acc[tt];
    }
    __syncthreads();
#pragma unroll
    for (int i = 0; i < 2; ++i) { const int idx = t + 512 * i, tt = idx >> 8, e = idx & 255;
        float qc = 0.f;
#pragma unroll
        for (int g = 0; g < 8; ++g) qc += part[(g * 4 + tt) * 256 + e];
        float num = sc[tt] * qc;
#pragma unroll
        for (int s = 0; s < 4; ++s) num += sc[32 + tt * 4 + s] * vS[s * 256 + e];
        HRAW[(size_t)(r0 + tt) * 1024 + hh * 256 + e] = f2bf(num / sc[48 + tt]);
    }
    if (t < 256) {
        float nn = sc[12] * nS[t];
#pragma unroll
        for (int s = 0; s < 4; ++s) nn += kwS[s * 256 + t];
        p.out[O_SN + (size_t)bh * 256 + t] = nn;
    }
    if (t == 0) p.out[O_SM + bh] = sc[13];
}

#define LBAR() do { asm volatile("s_waitcnt lgkmcnt(0)" ::: "memory"); __builtin_amdgcn_s_barrier(); asm volatile("" ::: "memory"); } while (0)
DI void mlstm_prompt_item(const Params& p, int item, unsigned char* lds) {
    const int t = tidx(), lane = t & 63, w = __builtin_amdgcn_readfirstlane(t >> 6);
    const int l31 = lane & 31, lh = lane >> 5;
    const int bh = item >> 3, es = item & 7, b = bh >> 2, hh = bh & 3;
    const bf16_t* P = (const bf16_t*)(p.ws + OFF_P);
    const float* LG = (const float*)(p.ws + OFF_LG);
    bf16_t* HRAW = (bf16_t*)(p.ws + OFF_HRAW);
    bf16_t* Qs = (bf16_t*)(lds);
    bf16_t* Ks0 = (bf16_t*)(lds + 33792);
    bf16_t* Vs0 = (bf16_t*)(lds + 101376);
    bf16_t* Ss = (bf16_t*)(lds + 111616);
    bf16_t* CTs = (bf16_t*)(lds + 120832);
    float* nS = (float*)(lds + 137728);
    float* sc0 = (float*)(lds + 138752);
    float* qnS = (float*)(lds + 141824);
    typedef short s16x4 __attribute__((ext_vector_type(4)));
    typedef __attribute__((address_space(3))) s16x4* lds_s16x4_p;
    const int trq = (lane & 15) >> 2, trc = 16 * ((lane >> 4) & 1) + 4 * (lane & 3);
#define TRFRAG(dst, img, pitch, k0, c0) do { \
        const s16x4 lo_ = __builtin_amdgcn_ds_read_tr16_b64_v4i16((lds_s16x4_p)((img) + ((k0) + 8 * lh + trq) * (pitch) + (c0) + trc)); \
        const s16x4 hi_ = __builtin_amdgcn_ds_read_tr16_b64_v4i16((lds_s16x4_p)((img) + ((k0) + 8 * lh + 4 + trq) * (pitch) + (c0) + trc)); \
        dst[0] = lo_[0]; dst[1] = lo_[1]; dst[2] = lo_[2]; dst[3] = lo_[3]; dst[4] = hi_[0]; dst[5] = hi_[1]; dst[6] = hi_[2]; dst[7] = hi_[3]; } while (0)
    for (int i = t; i < 16896 / 4; i += 512) ((unsigned*)CTs)[i] = 0u;
    if (t < 256) nS[t] = 0.f;
    f32x16 Cacc, accN, acc2;
#pragma unroll
    for (int r = 0; r < 16; ++r) { Cacc[r] = 0.f; accN[r] = 0.f; acc2[r] = 0.f; }
    float m_prev = 0.f;
    u32x4 qr[4], kr[4], vr; float li = 0.f, lf = 0.f;
    vr = (u32x4){0u, 0u, 0u, 0u};
    const size_t rbase = (size_t)b * 2048;
#define LOADCHUNK(j) do { const size_t r0_ = rbase + (size_t)(j) * 64; int tl_ = t; asm volatile("" : "+v"(tl_)); \
    _Pragma("unroll") for (int i = 0; i < 4; ++i) { const int idx = tl_ + 512 * i; \
        qr[i] = *(const u32x4*)(P + (r0_ + (idx >> 5)) * NP + 3072 + hh * 256 + 8 * (idx & 31)); \
        kr[i] = *(const u32x4*)(P + (r0_ + (idx >> 5)) * NP + 4096 + hh * 256 + 8 * (idx & 31)); } \
    if (t < 256) vr = *(const u32x4*)(P + (r0_ + (tl_ >> 2)) * NP + 5120 + hh * 256 + es * 32 + 8 * (tl_ & 3)); \
    if (w == 7) { li = LG[(r0_ + lane) * 8 + hh]; lf = LG[(r0_ + lane) * 8 + 4 + hh]; } } while (0)
    LOADCHUNK(0);
    bf16x8 ones;
#pragma unroll
    for (int j = 0; j < 8; ++j) ones[j] = (short)0x3F80;
#define STAGE_CHUNK(jn) do { bf16_t* const Kn = Ks0 + ((jn) & 1) * 16896; bf16_t* const Vn = Vs0 + ((jn) & 1) * 2560; float* const scn = sc0 + ((jn) & 1) * 384; \
        int ta = t; asm volatile("" : "+v"(ta)); \
        _Pragma("unroll") \
        for (int i = 0; i < 4; ++i) { const int idx = ta + 512 * i; \
            *(u32x4*)(Qs + (idx >> 5) * 264 + 8 * (idx & 31)) = qr[i]; \
            *(u32x4*)(Kn + (idx >> 5) * 264 + 8 * (idx & 31)) = kr[i]; } \
        if (t < 256) *(u32x4*)(Vn + (ta >> 2) * 40 + 8 * (ta & 3)) = vr; \
        if (w == 7) { \
            float bs = lf; \
        _Pragma("unroll") \
            for (int o = 1; o < 64; o <<= 1) { const float n = __shfl_up(bs, o); if (lane >= o) bs += n; } \
            const float g = li - bs; \
            float gm = g; \
        _Pragma("unroll") \
            for (int o = 1; o < 64; o <<= 1) { const float n = __shfl_up(gm, o); if (lane >= o) gm = fmaxf(gm, n); } \
            const float mx = fmaxf(m_prev, gm); \
            const float mt = bs + mx, rw = -mx; \
            const float inter = __expf(rw + m_prev); \
            const float row63 = __shfl(rw, 63); \
            const float g16 = g - 2.772588722239781f; \
            scn[lane] = __expf(rw); scn[64 + lane] = __expf(g16); scn[128 + lane] = inter; scn[192 + lane] = __expf(-mt); scn[256 + lane] = __expf(g16 + row63); \
            m_prev = __shfl(mt, 63); \
        } } while (0)
    STAGE_CHUNK(0);
    for (int j = 0; j < 32; ++j) {
        bf16_t* const Ks = Ks0 + (j & 1) * 16896; bf16_t* const Vs = Vs0 + (j & 1) * 2560;
        float* const rowS = sc0 + (j & 1) * 384; float* const colS = rowS + 64; float* const interS = rowS + 128; float* const emtS = rowS + 192; float* const wcS = rowS + 256;
        LBAR();
        if (j + 1 < 32) LOADCHUNK(j + 1);
        if (w < 4) {
            const int tb = w >> 1, sb = w & 1;
            f32x16 acc;
#pragma unroll
            for (int r = 0; r < 16; ++r) acc[r] = 0.f;
            if (sb <= tb) {
#pragma unroll 4
                for (int ks = 0; ks < 16; ++ks) {
                    const bf16x8 a = *(const bf16x8*)(Qs + (tb * 32 + l31) * 264 + ks * 16 + 8 * lh);
                    const bf16x8 bq = *(const bf16x8*)(Ks + (sb * 32 + l31) * 264 + ks * 16 + 8 * lh);
                    acc = MFMA32(a, bq, acc);
                }
            }
            const int s = sb * 32 + l31; const float cs = colS[s];
#pragma unroll
            for (int r = 0; r < 16; ++r) { const int tr = tb * 32 + crow(r, lh);
                const float val = (s <= tr) ? acc[r] * (rowS[tr] * cs) : 0.f;
                Ss[tr * 72 + s] = f2bf(val); }
        } else if (w < 6) {
            const int tb = w - 4;
#pragma unroll
            for (int r = 0; r < 16; ++r) acc2[r] = 0.f;
#pragma unroll 4
            for (int ks = 0; ks < 16; ++ks) {
                const bf16x8 a = *(const bf16x8*)(Qs + (tb * 32 + l31) * 264 + ks * 16 + 8 * lh);
                const bf16x8 bc = *(const bf16x8*)(CTs + l31 * 264 + ks * 16 + 8 * lh);
                acc2 = MFMA32(a, bc, acc2);
            }
        } else {
            const int tb = w - 6;
            f32x16 accq;
#pragma unroll
            for (int r = 0; r < 16; ++r) accq[r] = 0.f;
#pragma unroll 4
            for (int ks = 0; ks < 16; ++ks) {
                const bf16x8 a = *(const bf16x8*)(Qs + (tb * 32 + l31) * 264 + ks * 16 + 8 * lh);
                const float4 n0 = *(const float4*)(nS + ks * 16 + 8 * lh), n1 = *(const float4*)(nS + ks * 16 + 8 * lh + 4);
                u32x4 nb; nb.x = cvt_pk_bf16(n0.x, n0.y); nb.y = cvt_pk_bf16(n0.z, n0.w); nb.z = cvt_pk_bf16(n1.x, n1.y); nb.w = cvt_pk_bf16(n1.z, n1.w);
                if (l31 != 0) nb = (u32x4){0u, 0u, 0u, 0u};
                accq = MFMA32(a, __builtin_bit_cast(bf16x8, nb), accq);
            }
            if (l31 == 0) {
#pragma unroll
                for (int r = 0; r < 16; ++r) qnS[tb * 32 + crow(r, lh)] = accq[r];
            }
        }
        LBAR();
        if (w == 4 || w == 5) {
            const int tb = w - 4;
            f32x16 accS, accD;
#pragma unroll
            for (int r = 0; r < 16; ++r) { accS[r] = 0.f; accD[r] = 0.f; }
#pragma unroll
            for (int ks = 0; ks < 4; ++ks) {
                const bf16x8 a = *(const bf16x8*)(Ss + (tb * 32 + l31) * 72 + ks * 16 + 8 * lh);
                bf16x8 bv; TRFRAG(bv, Vs, 40, ks * 16, 0);
                accS = MFMA32(a, bv, accS);
                accD = MFMA32(a, ones, accD);
            }
            const size_t r0 = rbase + (size_t)j * 64;
#pragma unroll
            for (int r = 0; r < 16; ++r) { const int tr = tb * 32 + crow(r, lh);
                const float it = interS[tr];
                const float den = accD[r] + it * qnS[tr];
                const float dn = fmaxf(fabsf(den), emtS[tr]);
                const float hv = (accS[r] + it * acc2[r]) * __builtin_amdgcn_rcpf(dn);
                HRAW[(r0 + tr) * 1024 + hh * 256 + es * 32 + l31] = f2bf(hv); }
        }
        {
            const float dc = interS[63];
#pragma unroll
            for (int r = 0; r < 16; ++r) { Cacc[r] *= dc; accN[r] *= dc; }
#pragma unroll
            for (int ks = 0; ks < 4; ++ks) {
                bf16x8 kt; TRFRAG(kt, Ks, 264, ks * 16, w * 32);
                bf16x8 vt; TRFRAG(vt, Vs, 40, ks * 16, 0);
                float vf[8]; unpack8(__builtin_bit_cast(u32x4, vt), vf);
                const float4 wa = *(const float4*)(wcS + ks * 16 + 8 * lh), wb = *(const float4*)(wcS + ks * 16 + 8 * lh + 4);
                vf[0] *= wa.x; vf[1] *= wa.y; vf[2] *= wa.z; vf[3] *= wa.w; vf[4] *= wb.x; vf[5] *= wb.y; vf[6] *= wb.z; vf[7] *= wb.w;
                const u32x4 pk = pack8(vf);
                Cacc = MFMA32(kt, __builtin_bit_cast(bf16x8, pk), Cacc);
                u32x4 nb; nb.x = cvt_pk_bf16(wa.x, wa.y); nb.y = cvt_pk_bf16(wa.z, wa.w); nb.z = cvt_pk_bf16(wb.x, wb.y); nb.w = cvt_pk_bf16(wb.z, wb.w);
                if (l31 != 0) nb = (u32x4){0u, 0u, 0u, 0u};
                accN = MFMA32(kt, __builtin_bit_cast(bf16x8, nb), accN);
            }
#pragma unroll
            for (int g = 0; g < 4; ++g) { u32x2 o; o.x = cvt_pk_bf16(Cacc[4 * g], Cacc[4 * g + 1]); o.y = cvt_pk_bf16(Cacc[4 * g + 2], Cacc[4 * g + 3]);
                *(u32x2*)(CTs + l31 * 264 + w * 32 + 8 * g + 4 * lh) = o; }
            if (l31 == 0) {
#pragma unroll
                for (int r = 0; r < 16; ++r) nS[w * 32 + crow(r, lh)] = accN[r];
            }
        }
        if (j + 1 < 32) STAGE_CHUNK(j + 1);
    }
    LBAR();
#undef STAGE_CHUNK
#undef LOADCHUNK
#undef TRFRAG
    {
        float* oc = p.out + O_PC + (size_t)bh * 65536 + es * 32 + l31;
#pragma unroll
        for (int r = 0; r < 16; ++r) oc[(size_t)(w * 32 + crow(r, lh)) * 256] = Cacc[r];
        if (es == 0) {
            if (t < 256) p.out[O_PN + (size_t)bh * 256 + t] = nS[t];
            if (w == 7 && lane == 0) p.out[O_PM + bh] = m_prev;
        }
    }
}

DI void phase3(const Params& p, unsigned char* lds, int ctr_off) {
    unsigned* ctr = (unsigned*)(p.ws + OFF_CTL) + ctr_off;
    for (int rep = 0; rep < ((DUPMASK & 4096) ? 2 : 1); ++rep)
    for (int it = blockIdx.x; it < 128; it += gridDim.x) { __syncthreads(); mlstm_prompt_item(p, it, lds); }
    for (;;) {
        const int it = next_item(ctr, lds);
        if (it >= 512 + 136 + 704) break;
        if (it < 512) mlstm_sample_item(p, it, lds); else if (it < 648) conv_item(p, it - 512); else tr_w_up(p, it - 648 + 704, lds);
    }
}

DI void phase3b(const Params& p) {
    const int t = tidx(), lane = t & 63, w = t >> 6;
    const bf16_t* P = (const bf16_t*)(p.ws + OFF_P);
    const bf16_t* HRAW = (const bf16_t*)(p.ws + OFF_HRAW);
    bf16_t* MIXIN = (bf16_t*)(p.ws + OFF_MIXIN);
    const float* wn = p.in[14];
    const int nw = gridDim.x * 8, total = M * 4;
    for (int it0 = blockIdx.x * 8 + w; it0 < total; it0 += 4 * nw) {
        u32x2 hv[4], ov[4];
#pragma unroll
        for (int k = 0; k < 4; ++k) { const int it = it0 + k * nw < total ? it0 + k * nw : it0; const int row = it >> 2, hh = it & 3;
            hv[k] = *(const u32x2*)(HRAW + (size_t)row * 1024 + hh * 256 + 4 * lane);
            ov[k] = *(const u32x2*)(P + (size_t)row * NP + 6144 + hh * 256 + 4 * lane); }
#pragma unroll
        for (int k = 0; k < 4; ++k) {
            const int it = it0 + k * nw;
            if (it < total) {
                const int row = it >> 2, hh = it & 3;
                const float h0 = bf_lo(hv[k].x), h1 = bf_hi(hv[k].x), h2 = bf_lo(hv[k].y), h3 = bf_hi(hv[k].y);
                const float mu = wave_sum((h0 + h1) + (h2 + h3)) * (1.0f / 256.0f);
                const float a = h0 - mu, b = h1 - mu, c = h2 - mu, d = h3 - mu;
                const float rstd = rsqrtf(wave_sum((a * a + b * b) + (c * c + d * d)) * (1.0f / 256.0f) + LN_EPS);
                const float4 wv = *(const float4*)(wn + hh * 256 + 4 * lane);
                u32x2 o;
                o.x = cvt_pk_bf16(a * rstd * wv.x * sigmoidf_(bf_lo(ov[k].x)), b * rstd * wv.y * sigmoidf_(bf_hi(ov[k].x)));
                o.y = cvt_pk_bf16(c * rstd * wv.z * sigmoidf_(bf_lo(ov[k].y)), d * rstd * wv.w * sigmoidf_(bf_hi(ov[k].y)));
                *(u32x2*)(MIXIN + (size_t)row * D + 1024 + hh * 256 + 4 * lane) = o;
            }
        }
    }
}

DI void phase5(const Params& p) {
    const int t = tidx(), lane = t & 63, w = t >> 6;
    const float* MOD = (const float*)(p.ws + OFF_MOD);
    const bf16_t* MIX = (const bf16_t*)(p.ws + OFF_MIX);
    const float* PO = (const float*)(p.ws + OFF_PART_OUT);
    bf16_t* X1 = (bf16_t*)(p.ws + OFF_X1);
    bf16_t* U = (bf16_t*)(p.ws + OFF_U);
    const float* lg = p.in[16]; const float* lb = p.in[17];
    for (int row = blockIdx.x * 8 + w; row < M; row += gridDim.x * 8) {
        const float* xr = row < MP ? p.in[0] + (size_t)row * D : p.in[1] + (size_t)(row - MP) * D;
        const float* mod = MOD + (size_t)mod_row(row) * 12288;
        const bf16_t* mr = MIX + (size_t)row * D;
        float4 v[8]; float s = 0.f;
#pragma unroll
        for (int i = 0; i < 8; ++i) { const int c = (i * 64 + lane) * 4;
            const float4 x = *(const float4*)(xr + c), g = *(const float4*)(mod + 4096 + c);
            float4 m;
            if (row < MP) { const u32x2 mb = *(const u32x2*)(mr + c); m = make_float4(bf_lo(mb.x), bf_hi(mb.x), bf_lo(mb.y), bf_hi(mb.y)); }
            else { m = make_float4(0.f, 0.f, 0.f, 0.f);
#pragma unroll
                for (int ks = 0; ks < 8; ++ks) { const float4 q4 = *(const float4*)(PO + ((size_t)ks * MS + (row - MP)) * D + c); m.x += q4.x; m.y += q4.y; m.z += q4.z; m.w += q4.w; } }
            v[i].x = ALPHA * x.x + (1.0f + g.x) * m.x; v[i].y = ALPHA * x.y + (1.0f + g.y) * m.y; v[i].z = ALPHA * x.z + (1.0f + g.z) * m.z; v[i].w = ALPHA * x.w + (1.0f + g.w) * m.w;
            s += (v[i].x + v[i].y) + (v[i].z + v[i].w); }
        float mu = wave_sum(s) * (1.0f / 2048.0f); float q = 0.f;
#pragma unroll
        for (int i = 0; i < 8; ++i) { const float a = v[i].x - mu, b = v[i].y - mu, c = v[i].z - mu, d = v[i].w - mu; q += (a * a + b * b) + (c * c + d * d); }
        float rstd = rsqrtf(wave_sum(q) * (1.0f / 2048.0f) + LN_EPS);
        s = 0.f;
#pragma unroll
        for (int i = 0; i < 8; ++i) { const int c = (i * 64 + lane) * 4;
            const float4 gg = *(const float4*)(lg + c), bb = *(const float4*)(lb + c);
            v[i].x = (v[i].x - mu) * rstd * gg.x + bb.x; v[i].y = (v[i].y - mu) * rstd * gg.y + bb.y; v[i].z = (v[i].z - mu) * rstd * gg.z + bb.z; v[i].w = (v[i].w - mu) * rstd * gg.w + bb.w;
            { u32x2 xb; xb.x = cvt_pk_bf16(v[i].x, v[i].y); xb.y = cvt_pk_bf16(v[i].z, v[i].w); *(u32x2*)(X1 + (size_t)row * D + c) = xb; }
            s += (v[i].x + v[i].y) + (v[i].z + v[i].w); }
        mu = wave_sum(s) * (1.0f / 2048.0f); q = 0.f;
#pragma unroll
        for (int i = 0; i < 8; ++i) { const float a = v[i].x - mu, b = v[i].y - mu, c = v[i].z - mu, d = v[i].w - mu; q += (a * a + b * b) + (c * c + d * d); }
        rstd = rsqrtf(wave_sum(q) * (1.0f / 2048.0f) + LN_EPS);
#pragma unroll
        for (int i = 0; i < 8; ++i) { const int c = (i * 64 + lane) * 4;
            const float4 sh = *(const float4*)(mod + 6144 + c), sc = *(const float4*)(mod + 8192 + c);
            u32x2 o;
            o.x = cvt_pk_bf16((v[i].x - mu) * rstd * (1.0f + sc.x) + sh.x, (v[i].y - mu) * rstd * (1.0f + sc.y) + sh.y);
            o.y = cvt_pk_bf16((v[i].z - mu) * rstd * (1.0f + sc.z) + sh.z, (v[i].w - mu) * rstd * (1.0f + sc.w) + sh.w);
            *(u32x2*)(U + (size_t)row * D + c) = o; }
    }
}

DI void ffn_one(const float* z0, const float* z1, const float* z2, const float* gv, const float* w0, const float* w1, const float* w2, bf16_t* dst) {
    float y[8];
#pragma unroll
    for (int e = 0; e < 8; ++e) { const float ac = w0[e] * z0[e] + w1[e] * z1[e] + w2[e] * z2[e]; y[e] = siluf_(ac) * gv[e]; }
    *(u32x4*)dst = pack8(y);
}
DI void phase7(const Params& p) {
    const bf16_t* UP = (const bf16_t*)(p.ws + OFF_UP);
    bf16_t* HM = (bf16_t*)(p.ws + OFF_HMID);
    const float* wf = p.in[19];
    const int gtid = blockIdx.x * 512 + tidx(), gsz = gridDim.x * 512;
    const int nwalk = (MP / 16) * 704;
    for (int wk = gtid; wk < nwalk; wk += gsz) {
        const int rb = wk / 704, c8 = (wk - rb * 704) * 8, row0 = rb * 16, tp0 = row0 & 2047;
        float w0[8], w1[8], w2[8];
        { const float4 a0 = *(const float4*)(wf + c8), a1 = *(const float4*)(wf + c8 + 4);
          const float4 b0 = *(const float4*)(wf + DFF + c8), b1 = *(const float4*)(wf + DFF + c8 + 4);
          const float4 c0 = *(const float4*)(wf + 2 * DFF + c8), c1 = *(const float4*)(wf + 2 * DFF + c8 + 4);
          w0[0] = a0.x; w0[1] = a0.y; w0[2] = a0.z; w0[3] = a0.w; w0[4] = a1.x; w0[5] = a1.y; w0[6] = a1.z; w0[7] = a1.w;
          w1[0] = b0.x; w1[1] = b0.y; w1[2] = b0.z; w1[3] = b0.w; w1[4] = b1.x; w1[5] = b1.y; w1[6] = b1.z; w1[7] = b1.w;
          w2[0] = c0.x; w2[1] = c0.y; w2[2] = c0.z; w2[3] = c0.w; w2[4] = c1.x; w2[5] = c1.y; w2[6] = c1.z; w2[7] = c1.w; }
        float zm2[8], zm1[8];
        if (tp0 == 0) {
#pragma unroll
            for (int e = 0; e < 8; ++e) { zm2[e] = 0.f; zm1[e] = 0.f; }
        } else {
            unpack8(*(const u32x4*)(UP + (size_t)(row0 - 2) * NUP + c8), zm2);
            unpack8(*(const u32x4*)(UP + (size_t)(row0 - 1) * NUP + c8), zm1);
        }
        for (int q = 0; q < 16; q += 4) {
            u32x4 av[4], gv4[4];
#pragma unroll
            for (int k = 0; k < 4; ++k) { const bf16_t* pr = UP + (size_t)(row0 + q + k) * NUP + c8; av[k] = *(const u32x4*)pr; gv4[k] = *(const u32x4*)(pr + DFF); }
#pragma unroll
            for (int k = 0; k < 4; ++k) {
                float z[8], g[8]; unpack8(av[k], z); unpack8(gv4[k], g);
                ffn_one(zm2, zm1, z, g, w0, w1, w2, HM + (size_t)(row0 + q + k) * DFF + c8);
#pragma unroll
                for (int e = 0; e < 8; ++e) { zm2[e] = zm1[e]; zm1[e] = z[e]; }
            }
        }
        if (tp0 + 16 == 2048) {
            float* o = p.out + O_PFFN + (size_t)((row0 >> 11) * 2) * DFF + c8;
            *(float4*)(o) = make_float4(zm2[0], zm2[1], zm2[2], zm2[3]); *(float4*)(o + 4) = make_float4(zm2[4], zm2[5], zm2[6], zm2[7]);
            *(float4*)(o + DFF) = make_float4(zm1[0], zm1[1], zm1[2], zm1[3]); *(float4*)(o + DFF + 4) = make_float4(zm1[4], zm1[5], zm1[6], zm1[7]);
        }
    }
    const int total = MS * 704;
    for (int idx = gtid; idx < total; idx += gsz) {
        const int rr = idx / 704, c8 = (idx - rr * 704) * 8, row = MP + rr;
        const int b = rr >> 2, tp = rr & 3;
        float z[3][8];
#pragma unroll
        for (int j = 0; j < 3; ++j) {
            const int tq = tp - 2 + j;
            if (tq >= 0) unpack8(*(const u32x4*)(UP + (size_t)(row - 2 + j) * NUP + c8), z[j]);
            else { const float* sp = p.in[8] + (size_t)(b * 2 + tq + 2) * DFF + c8;
                const float4 s0 = *(const float4*)sp, s1 = *(const float4*)(sp + 4);
                z[j][0] = s0.x; z[j][1] = s0.y; z[j][2] = s0.z; z[j][3] = s0.w; z[j][4] = s1.x; z[j][5] = s1.y; z[j][6] = s1.z; z[j][7] = s1.w; }
        }
        float gv[8];
        unpack8(*(const u32x4*)(UP + (size_t)row * NUP + DFF + c8), gv);
        const float4 w0a = *(const float4*)(wf + c8), w0b = *(const float4*)(wf + c8 + 4);
        const float4 w1a = *(const float4*)(wf + DFF + c8), w1b = *(const float4*)(wf + DFF + c8 + 4);
        const float4 w2a = *(const float4*)(wf + 2 * DFF + c8), w2b = *(const float4*)(wf + 2 * DFF + c8 + 4);
        const float w0[8] = {w0a.x, w0a.y, w0a.z, w0a.w, w0b.x, w0b.y, w0b.z, w0b.w};
        const float w1[8] = {w1a.x, w1a.y, w1a.z, w1a.w, w1b.x, w1b.y, w1b.z, w1b.w};
        const float w2[8] = {w2a.x, w2a.y, w2a.z, w2a.w, w2b.x, w2b.y, w2b.z, w2b.w};
        ffn_one(z[0], z[1], z[2], gv, w0, w1, w2, HM + (size_t)row * DFF + c8);
        if (tp == 3) {
            float* o = p.out + O_SFFN + (size_t)(b * 2) * DFF + c8;
            *(float4*)(o) = make_float4(z[1][0], z[1][1], z[1][2], z[1][3]); *(float4*)(o + 4) = make_float4(z[1][4], z[1][5], z[1][6], z[1][7]);
            *(float4*)(o + DFF) = make_float4(z[2][0], z[2][1], z[2][2], z[2][3]); *(float4*)(o + DFF + 4) = make_float4(z[2][4], z[2][5], z[2][6], z[2][7]);
        }
    }
}

DI void phase9(const Params& p) {
    const int t = tidx(), lane = t & 63, w = t >> 6;
    const float* MOD = (const float*)(p.ws + OFF_MOD);
    const bf16_t* Y = (const bf16_t*)(p.ws + OFF_MIX);
    const float* PD = (const float*)(p.ws + OFF_PART_DOWN);
    const bf16_t* X1 = (const bf16_t*)(p.ws + OFF_X1);
    const float* lg = p.in[21]; const float* lb = p.in[22];
    for (int row = blockIdx.x * 8 + w; row < M; row += gridDim.x * 8) {
        const float* mod = MOD + (size_t)mod_row(row) * 12288;
        float4 v[8]; float s = 0.f;
#pragma unroll
        for (int i = 0; i < 8; ++i) { const int c = (i * 64 + lane) * 4;
            const u32x2 xb = *(const u32x2*)(X1 + (size_t)row * D + c);
            const float4 x = make_float4(bf_lo(xb.x), bf_hi(xb.x), bf_lo(xb.y), bf_hi(xb.y)), g = *(const float4*)(mod + 10240 + c);
            float4 m;
            if (row < MP) { const u32x2 mb = *(const u32x2*)(Y + (size_t)row * D + c); m = make_float4(bf_lo(mb.x), bf_hi(mb.x), bf_lo(mb.y), bf_hi(mb.y)); }
            else { m = make_float4(0.f, 0.f, 0.f, 0.f);
#pragma unroll
                for (int ks = 0; ks < 11; ++ks) { const float4 q4 = *(const float4*)(PD + ((size_t)ks * MS + (row - MP)) * D + c); m.x += q4.x; m.y += q4.y; m.z += q4.z; m.w += q4.w; } }
            v[i].x = ALPHA * x.x + (1.0f + g.x) * m.x; v[i].y = ALPHA * x.y + (1.0f + g.y) * m.y; v[i].z = ALPHA * x.z + (1.0f + g.z) * m.z; v[i].w = ALPHA * x.w + (1.0f + g.w) * m.w;
            s += (v[i].x + v[i].y) + (v[i].z + v[i].w); }
        const float mu = wave_sum(s) * (1.0f / 2048.0f); float q = 0.f;
#pragma unroll
        for (int i = 0; i < 8; ++i) { const float a = v[i].x - mu, b = v[i].y - mu, c = v[i].z - mu, d = v[i].w - mu; q += (a * a + b * b) + (c * c + d * d); }
        const float rstd = rsqrtf(wave_sum(q) * (1.0f / 2048.0f) + LN_EPS);
#pragma unroll
        for (int i = 0; i < 8; ++i) { const int c = (i * 64 + lane) * 4;
            const float4 gg = *(const float4*)(lg + c), bb = *(const float4*)(lb + c);
            float4 o;
            o.x = (v[i].x - mu) * rstd * gg.x + bb.x; o.y = (v[i].y - mu) * rstd * gg.y + bb.y; o.z = (v[i].z - mu) * rstd * gg.z + bb.z; o.w = (v[i].w - mu) * rstd * gg.w + bb.w;
            *(float4*)(p.out + (size_t)row * D + c) = o; }
    }
}

#define XB_TMO      128
#define XB_XCNT(j)  (256  + 64 * (j))
#define XB_XSUB(j)  (1280 + 64 * (j))
#define XB_XGEN(j)  (2304 + 64 * (j))
#define XB_TOP      3328
#define XB_TOPGEN   3392
#define XCD_BAR_WORDS 3456
#define XB_SPIN_CAP (1u << 18)
#define XLAS __attribute__((address_space(3)))
DI unsigned xb_ld(unsigned* p)              { return __hip_atomic_load(p, __ATOMIC_RELAXED, __HIP_MEMORY_SCOPE_AGENT); }
DI unsigned xb_add(unsigned* p, unsigned v) { return __hip_atomic_fetch_add(p, v, __ATOMIC_RELAXED, __HIP_MEMORY_SCOPE_AGENT); }
DI unsigned xb_xcc_id() { return (unsigned)__builtin_amdgcn_s_getreg((3 << 11) | 20) & 0xFu; }
#define XB_SPIN(cond, bar) do { unsigned _sp = 0; while (cond) { __builtin_amdgcn_s_sleep(1); \
    if ((++_sp & 255u) == 0u) { if (xb_ld(&(bar)[XB_TMO])) break; if (_sp > XB_SPIN_CAP) { atomicAdd(&(bar)[XB_TMO], 1u); break; } } } } while (0)
struct XcdBarrier { unsigned* bar; unsigned x; volatile XLAS unsigned* st; };
DI XcdBarrier xcd_barrier_post(unsigned* bar, volatile XLAS unsigned* st) {
    XcdBarrier b; b.bar = bar; b.x = xb_xcc_id(); b.st = st;
    if (threadIdx.x == 0) (void)xb_add(&bar[XB_XCNT(b.x)], 1u);
    return b;
}
DI void xcd_barrier_complete(unsigned* bar, unsigned x, unsigned& nloc, unsigned& nx) {
    const unsigned G = gridDim.x * gridDim.y * gridDim.z;
    unsigned sum, cnt, mine, sp = 0u;
    for (;;) {
        sum = 0u; cnt = 0u; mine = 0u;
#pragma unroll
        for (unsigned j = 0; j < 16; ++j) { const unsigned c = xb_ld(&bar[XB_XCNT(j)]); sum += c; cnt += (c > 0u) ? 1u : 0u; mine = (j == x) ? c : mine; }
        if (sum == G) break;
        __builtin_amdgcn_s_sleep(1);
        if ((++sp & 255u) == 0u) { if (xb_ld(&bar[XB_TMO])) break; if (sp > XB_SPIN_CAP) { atomicAdd(&bar[XB_TMO], 1u); break; } }
    }
    nloc = mine > 0u ? mine : 1u; nx = cnt > 0u ? cnt : 1u;
}
DI void xcd_barrier(const XcdBarrier& b) {
    asm volatile("s_waitcnt vmcnt(0)" ::: "memory");
    __syncthreads();
    if (threadIdx.x == 0) {
        unsigned* bar = b.bar;
        __builtin_amdgcn_s_waitcnt(0);
        unsigned nloc = b.st[0], nx = b.st[1];
        if (nloc == 0u) { xcd_barrier_complete(bar, b.x, nloc, nx); b.st[0] = nloc; b.st[1] = nx; }
        const unsigned old = xb_add(&bar[XB_XSUB(b.x)], 1u);
        const unsigned gen = old / nloc;
        if (old + 1u == (gen + 1u) * nloc) {
            __builtin_amdgcn_fence(__ATOMIC_RELEASE, "agent");
            asm volatile("s_waitcnt vmcnt(0)" ::: "memory");
            const unsigned og = xb_add(&bar[XB_TOP], 1u);
            const unsigned tg = og / nx;
            if (og + 1u == (tg + 1u) * nx) xb_add(&bar[XB_TOPGEN], 1u);
            else XB_SPIN(xb_ld(&bar[XB_TOPGEN]) == tg, bar);
            __builtin_amdgcn_fence(__ATOMIC_ACQUIRE, "agent");
            xb_add(&bar[XB_XGEN(b.x)], 1u);
            asm volatile("s_waitcnt vmcnt(0)" ::: "memory");
        } else {
            XB_SPIN(xb_ld(&bar[XB_XGEN(b.x)]) == gen, bar);
            __builtin_amdgcn_fence(__ATOMIC_ACQUIRE, "agent");
            asm volatile("s_waitcnt vmcnt(0)" ::: "memory");
        }
    }
    __syncthreads();
}

__global__ void __launch_bounds__(512, 2) fwd_megakernel(Params p) {
    extern __shared__ __attribute__((aligned(16))) unsigned char shm[];
    cg::grid_group grid = cg::this_grid();
    const int lo = p.ph_lo, hi = p.ph_hi;
    if (threadIdx.x < 4) ((volatile unsigned*)(shm + LDS_SLOT + 16))[threadIdx.x] = 0u;
    __syncthreads();
    XcdBarrier xbar; xbar.bar = (unsigned*)(p.ws + OFF_CTL + 4096); xbar.x = 0; xbar.st = (volatile XLAS unsigned*)(shm + LDS_SLOT + 16);
    if (hi - lo > 1) xbar = xcd_barrier_post((unsigned*)(p.ws + OFF_CTL + 4096), (volatile XLAS unsigned*)(shm + LDS_SLOT + 16));
    if (lo < 0) grid.sync();
#define IN(k) (lo <= (k) && (k) < hi)
#define SEAM(k) do { if (IN(k) && IN((k) + 1)) { if (DUPMASK & 2048) xcd_barrier(xbar); xcd_barrier(xbar); } } while (0)
    if (IN(0)) { phase0(p, shm, 0); if (DUPMASK & 1) phase0(p, shm, 128); }
    SEAM(0);
    if (IN(1)) { phase1(p, shm); if (DUPMASK & 2) { __syncthreads(); phase1(p, shm); } }
    SEAM(1);
    if (IN(2)) {
        __syncthreads();
        pg8::Gemm g{(const bf16_t*)(p.ws + OFF_U), (const bf16_t*)(p.ws + OFF_WT_IN), M, NP, D, D, D};
        pg8::StaticOrder S; S.init(M, NP, (int)gridDim.x, (int)blockIdx.x);
        pg8::EpiBf16 E{(bf16_t*)(p.ws + OFF_P), NP};
        pg8::gemm_phase<pg8::EpiBf16, pg8::StaticOrder>((PG8_LAS unsigned char*)shm, g, S, E);
        {
            const int nun = (M / 256) * (NP / 256), G = (int)gridDim.x, rounds = (nun + G - 1) / G;
            if (nun % G == 0 || (rounds - 1) * G + (int)blockIdx.x >= nun) phase2_idle(p, shm, 256);
        }
    }
    SEAM(2);
    if (IN(3)) { phase3(p, shm, 64); if (DUPMASK & 8) phase3(p, shm, 192); }
    SEAM(3);
    if (IN(4)) { phase3b(p); if (DUPMASK & 16) phase3b(p); }
    SEAM(4);
    if (IN(5)) {
        __syncthreads();
        pg8::Gemm g{(const bf16_t*)(p.ws + OFF_MIXIN), (const bf16_t*)(p.ws + OFF_WT_OUT), MP, D, D, D, D};
        pg8::StaticOrder S; S.init(MP, D, (int)gridDim.x, (int)blockIdx.x);
        pg8::EpiBf16 E{(bf16_t*)(p.ws + OFF_MIX), D};
        pg8::gemm_phase<pg8::EpiBf16, pg8::StaticOrder>((PG8_LAS unsigned char*)shm, g, S, E);
        pg8::Gemm g2{(const bf16_t*)(p.ws + OFF_MIXIN) + (size_t)MP * D, (const bf16_t*)(p.ws + OFF_WT_OUT), MS, D, 256, D, D};
        pg8::SplitOrder S2; S2.init(8, 256, (int)gridDim.x, (int)blockIdx.x);
        pg8::EpiF32 E2{(float*)(p.ws + OFF_PART_OUT), D, (size_t)MS * D};
        pg8::gemm_phase<pg8::EpiF32, pg8::SplitOrder>((PG8_LAS unsigned char*)shm, g2, S2, E2);
    }
    SEAM(5);
    if (IN(6)) { phase5(p); if (DUPMASK & 64) phase5(p); }
    SEAM(6);
    if (IN(7)) {
        __syncthreads();
        pg8::Gemm g{(const bf16_t*)(p.ws + OFF_U), (const bf16_t*)(p.ws + OFF_WT_UP), M, NUP, D, D, D};
        pg8::StaticOrder S; S.init(M, NUP, (int)gridDim.x, (int)blockIdx.x);
        pg8::EpiBf16 E{(bf16_t*)(p.ws + OFF_UP), NUP};
        pg8::gemm_phase<pg8::EpiBf16, pg8::StaticOrder>((PG8_LAS unsigned char*)shm, g, S, E);
    }
    SEAM(7);
    if (IN(8)) { phase7(p); if (DUPMASK & 256) phase7(p); }
    SEAM(8);
    if (IN(9)) {
        __syncthreads();
        pg8::Gemm g{(const bf16_t*)(p.ws + OFF_HMID), (const bf16_t*)(p.ws + OFF_WT_DOWN), MP, D, DFF, DFF, DFF};
        pg8::StaticOrder S; S.init(MP, D, (int)gridDim.x, (int)blockIdx.x);
        pg8::EpiBf16 E{(bf16_t*)(p.ws + OFF_MIX), D};
        pg8::gemm_phase<pg8::EpiBf16, pg8::StaticOrder>((PG8_LAS unsigned char*)shm, g, S, E);
        pg8::Gemm g2{(const bf16_t*)(p.ws + OFF_HMID) + (size_t)MP * DFF, (const bf16_t*)(p.ws + OFF_WT_DOWN), MS, D, 512, DFF, DFF};
        pg8::SplitOrder S2; S2.init(11, 512, (int)gridDim.x, (int)blockIdx.x);
        pg8::EpiF32 E2{(float*)(p.ws + OFF_PART_DOWN), D, (size_t)MS * D};
        pg8::gemm_phase<pg8::EpiF32, pg8::SplitOrder>((PG8_LAS unsigned char*)shm, g2, S2, E2);
    }
    SEAM(9);
    if (IN(10)) { phase9(p); if (DUPMASK & 1024) phase9(p); }
#undef IN
#undef SEAM
}
constexpr int N_PHASES = 11;

extern "C" void kernel_launch(void* const* d_in, const int* in_sizes, int n_in, void* d_out, int out_size, void* d_ws, size_t ws_size, hipStream_t stream) {
    static int grid_blocks = 0;
    if (grid_blocks == 0) {
        if (n_in != 23 || ws_size < WS_END) { fprintf(stderr, "kernel_launch: unexpected n_in %d or ws_size %zu (< %zu)\n", n_in, ws_size, (size_t)WS_END); grid_blocks = -1; return; }
        int dev = 0, cus = 0, per_cu = 0;
        hipGetDevice(&dev);
        hipDeviceGetAttribute(&cus, hipDeviceAttributeMultiprocessorCount, dev);
        if (hipFuncSetAttribute((const void*)fwd_megakernel, hipFuncAttributeMaxDynamicSharedMemorySize, LDS_BYTES) != hipSuccess) { fprintf(stderr, "kernel_launch: hipFuncSetAttribute failed\n"); grid_blocks = -1; return; }
        hipOccupancyMaxActiveBlocksPerMultiprocessor(&per_cu, (const void*)fwd_megakernel, 512, LDS_BYTES);
        if (per_cu < 1) { fprintf(stderr, "kernel_launch: occupancy query says %d blocks per CU\n", per_cu); per_cu = 1; }
        grid_blocks = cus * per_cu;
        (void)hipGetLastError();
    }
    if (grid_blocks < 0) return;
    (void)hipMemsetAsync((char*)d_ws + OFF_CTL, 0, CTL_BYTES, stream);
    Params p{};
    for (int i = 0; i < 23; ++i) p.in[i] = (const float*)d_in[i];
    p.out = (float*)d_out; p.ws = (unsigned char*)d_ws;
#if MK_MULTI
    for (int ph = 0; ph < N_PHASES; ++ph) {
        p.ph_lo = ph; p.ph_hi = ph + 1;
        hipLaunchKernelGGL(fwd_megakernel, dim3(grid_blocks), dim3(512), LDS_BYTES, stream, p);
    }
#else
    p.ph_lo = 0; p.ph_hi = N_PHASES;
    void* args[] = {&p};
    hipError_t e = hipLaunchCooperativeKernel((const void*)fwd_megakernel, dim3(grid_blocks), dim3(512), args, LDS_BYTES, stream);
    if (e != hipSuccess) fprintf(stderr, "cooperative launch failed: %s (grid %d)\n", hipGetErrorString(e), grid_blocks);
#endif
}
```

```cpp
#include <hip/hip_runtime.h>
#include <hip/hip_cooperative_groups.h>
#include <cstdio>
namespace cg = cooperative_groups;

#ifndef DUPMASK
#define DUPMASK 0
#endif
#ifndef MK_MULTI
#define MK_MULTI 0
#endif

#define DI __device__ __forceinline__
typedef unsigned short bf16_t;
typedef short bf16x8 __attribute__((ext_vector_type(8)));
typedef float f32x4 __attribute__((ext_vector_type(4)));
typedef float f32x16 __attribute__((ext_vector_type(16)));
typedef unsigned u32x4 __attribute__((ext_vector_type(4)));
typedef unsigned u32x2 __attribute__((ext_vector_type(2)));

constexpr int D = 2048, MP = 8192, MS = 512, M = 8704;
constexpr int NP = 7168, INC = 7176, DFF = 5632, NUP = 11264;
constexpr float LN_EPS = 1e-5f;
constexpr float ALPHA = 1.189207115002721f;

constexpr size_t OFF_WT_IN = 0;
constexpr size_t OFF_WT_OUT = OFF_WT_IN + (size_t)NP * D * 2;
constexpr size_t OFF_WT_UP = OFF_WT_OUT + (size_t)D * D * 2;
constexpr size_t OFF_U = OFF_WT_UP + (size_t)NUP * D * 2;
constexpr size_t OFF_HMID = 0;
constexpr size_t OFF_WT_DOWN = OFF_U + (size_t)M * D * 2;
constexpr size_t OFF_MOD = OFF_WT_DOWN + (size_t)D * DFF * 2;
constexpr size_t OFF_LG = OFF_MOD + (size_t)132 * 12288 * 4;
constexpr size_t OFF_CTL = OFF_LG + (size_t)M * 8 * 4;
constexpr size_t CTL_BYTES = 4096 + 16384;
constexpr size_t OFF_MIX = OFF_CTL + CTL_BYTES;
constexpr size_t OFF_X1 = OFF_MIX + (size_t)M * D * 4;
constexpr size_t OFF_E = OFF_X1 + (size_t)M * D * 4;
constexpr size_t OFF_P = OFF_E;
constexpr size_t OFF_MIXIN = OFF_P + (size_t)M * NP * 2;
constexpr size_t OFF_HRAW = OFF_MIXIN + (size_t)M * D * 2;
constexpr size_t OFF_UP = OFF_E;
constexpr size_t OFF_PART_OUT = OFF_P;
constexpr size_t OFF_PART_DOWN = OFF_E;
constexpr size_t WS_END = OFF_E + (size_t)M * NUP * 2;
static_assert((size_t)M * DFF * 2 <= OFF_WT_DOWN, "HMID alias");
static_assert(OFF_HRAW + (size_t)M * 1024 * 2 <= WS_END, "region E");

constexpr size_t O_YS = 16777216, O_PCONV = 17825792, O_PC = 17833984, O_PN = 18882560, O_PM = 18886656, O_PFFN = 18886672,
                 O_SCONV = 18931728, O_SC = 19193872, O_SN = 52748304, O_SM = 52879376, O_SFFN = 52879888;

constexpr int LDS_BYTES = 147456;
constexpr int LDS_SLOT = LDS_BYTES - 64;

struct Params { const float* in[23]; float* out; unsigned char* ws; int ph_lo, ph_hi; };

typedef __bf16 bf16v2_t __attribute__((ext_vector_type(2)));
typedef float f32x2_t __attribute__((ext_vector_type(2)));
DI unsigned cvt_pk_bf16(float lo, float hi) { const f32x2_t v = {lo, hi}; return __builtin_bit_cast(unsigned, __builtin_convertvector(v, bf16v2_t)); }
DI float bf_lo(unsigned u) { return __uint_as_float(u << 16); }
DI float bf_hi(unsigned u) { return __uint_as_float(u & 0xffff0000u); }
DI float bf2f(bf16_t v) { return __uint_as_float(((unsigned)v) << 16); }
DI bf16_t f2bf(float f) { return (bf16_t)(cvt_pk_bf16(f, 0.f) & 0xffffu); }
DI float wave_sum(float v) {
#pragma unroll
    for (int o = 32; o > 0; o >>= 1) v += __shfl_xor(v, o);
    return v;
}
DI float sigmoidf_(float x) { return 1.0f / (1.0f + __expf(-x)); }
DI float siluf_(float x) { return x / (1.0f + __expf(-x)); }
DI int crow(int r, int h) { return (r & 3) + 8 * (r >> 2) + 4 * h; }
DI int tidx() { int t = threadIdx.x; asm volatile("" : "+v"(t)); return t; }
DI void unpack8(const u32x4 v, float* f) {
    f[0] = bf_lo(v.x); f[1] = bf_hi(v.x); f[2] = bf_lo(v.y); f[3] = bf_hi(v.y);
    f[4] = bf_lo(v.z); f[5] = bf_hi(v.z); f[6] = bf_lo(v.w); f[7] = bf_hi(v.w);
}
DI u32x4 pack8(const float* f) {
    u32x4 r; r.x = cvt_pk_bf16(f[0], f[1]); r.y = cvt_pk_bf16(f[2], f[3]); r.z = cvt_pk_bf16(f[4], f[5]); r.w = cvt_pk_bf16(f[6], f[7]); return r;
}
#define MFMA32(a, b, c) __builtin_amdgcn_mfma_f32_32x32x16_bf16((a), (b), (c), 0, 0, 0)

DI int next_item(unsigned* ctr, unsigned char* lds) {
    volatile int* slot = (volatile int*)(lds + LDS_SLOT);
    __syncthreads();
    if (threadIdx.x == 0) *slot = (int)atomicAdd(ctr, 1u);
    __syncthreads();
    return *slot;
}

namespace pg8 {
#define PG8_LAS __attribute__((address_space(3)))
constexpr int BM = 256, BK = 64, HALF = 128, HTB = HALF * BK * 2, STAGE_BYTES = 8 * HTB, NXCD = 8, WGM = 8;
DI int lds_byte(int r, int c) { const int st = (r >> 4) * 2 + (c >> 5), rr = r & 15, cc = c & 31, ob = rr * 64 + cc * 2; return st * 1024 + (ob ^ (((ob >> 9) & 1) << 5)); }
DI void stage_rc(int b, int& R, int& C) { const int st = b / 1024, sb = b % 1024, swz = sb ^ (((sb >> 9) & 1) << 5); R = (st >> 1) * 16 + swz / 64; C = (st & 1) * 32 + (swz % 64) / 2; }
DI int perm32(int rho) { const int n = rho >> 4, i = rho & 15; return 8 * (i >> 2) + 4 * n + (i & 3); }
struct Unit { int pm, pn, ks, ko; };
struct Gemm { const bf16_t* A; const bf16_t* Bt; int M, N, K, lda, ldb; };
struct StaticOrder {
    int nM, nN, nwg, G, c;
    DI void init(int M_, int N_, int G_, int c_) { nM = M_ / BM; nN = N_ / BM; nwg = nM * nN; G = G_; c = c_; }
    DI bool next(int i, Unit& u) const {
        const long L = (long)i * G + c; if (L >= nwg) return false;
        int wgid = (int)L; { const int q = nwg / NXCD, r = nwg % NXCD, xcd = wgid % NXCD, off = wgid / NXCD; wgid = (xcd < r ? xcd * (q + 1) : r * (q + 1) + (xcd - r) * q) + off; }
        const int nig = WGM * nN, gid = wgid / nig, fm = gid * WGM, gsz = (nM - fm) < WGM ? (nM - fm) : WGM;
        u.pm = fm + ((wgid % nig) % gsz); u.pn = (wgid % nig) / gsz; u.ks = 0; u.ko = 0; return true;
    }
    DI void a_ready(const Unit&) const {}
    DI void done(const Unit&) const {}
};
struct SplitOrder {
    int nunits, G, c, kslice;
    DI void init(int S_, int kslice_, int G_, int c_) { nunits = 16 * S_; kslice = kslice_; G = G_; c = c_; }
    DI bool next(int i, Unit& u) const {
        const int L = i * G + c; if (L >= nunits) return false;
        u.pn = L & 7; u.pm = (L >> 3) & 1; u.ks = L >> 4; u.ko = u.ks * kslice; return true;
    }
    DI void a_ready(const Unit&) const {}
    DI void done(const Unit&) const {}
};
struct EpiF32 {
    static constexpr bool PERM = false;
    float* C; int ldc; size_t split_stride;
    DI void operator()(const f32x4 (&acc)[2][2][4][2], const Unit& u, int wr, int wc, int fr, int fq) const {
        const int row0 = u.pm * BM + wr * 64 + fr, col0 = u.pn * BM + wc * 32 + 4 * fq;
        float* const Cb = C + (size_t)u.ks * split_stride;
#pragma unroll
        for (int ai = 0; ai < 2; ++ai)
#pragma unroll
            for (int m = 0; m < 4; ++m) { float* rowp = Cb + (size_t)(row0 + ai * HALF + m * 16) * ldc + col0;
#pragma unroll
                for (int bj = 0; bj < 2; ++bj)
#pragma unroll
                    for (int n = 0; n < 2; ++n) *(f32x4*)(rowp + bj * HALF + n * 16) = acc[ai][bj][m][n]; }
    }
};
struct EpiBf16 {
    static constexpr bool PERM = true;
    bf16_t* O; int ldc;
    DI void operator()(const f32x4 (&acc)[2][2][4][2], const Unit& u, int wr, int wc, int fr, int fq) const {
        const int row0 = u.pm * BM + wr * 64 + fr; const int col0 = u.pn * BM + wc * 32 + 8 * fq;
#pragma unroll
        for (int ai = 0; ai < 2; ++ai)
#pragma unroll
            for (int m = 0; m < 4; ++m) { bf16_t* rowp = O + (size_t)(row0 + ai * HALF + m * 16) * ldc + col0;
#pragma unroll
                for (int bj = 0; bj < 2; ++bj) { const f32x4 v0 = acc[ai][bj][m][0], v1 = acc[ai][bj][m][1];
                    u32x4 w; w.x = cvt_pk_bf16(v0[0], v0[1]); w.y = cvt_pk_bf16(v0[2], v0[3]); w.z = cvt_pk_bf16(v1[0], v1[1]); w.w = cvt_pk_bf16(v1[2], v1[3]);
                    *(u32x4*)(rowp + bj * HALF) = w; } }
    }
};

template <class Epi, class Sched>
DI void gemm_phase(PG8_LAS unsigned char* lds, const Gemm g, const Sched& S, const Epi& E) {
    const int tid = tidx(), wid = __builtin_amdgcn_readfirstlane(tid >> 6), lane = tid & 63, wr = wid >> 2, wc = wid & 3, fr = lane & 15, fq = lane >> 4;
    const int K = g.K, nt = K / BK;
    unsigned voffA[2], voffB[2];
#pragma unroll
    for (int i = 0; i < 2; ++i) { int R, C; stage_rc(tid * 16 + i * 8192, R, C); const int Rb = Epi::PERM ? ((R & ~31) + perm32(R & 31)) : R;
        voffA[i] = (unsigned)(R * g.lda + C) * 2u; voffB[i] = (unsigned)(Rb * g.ldb + C) * 2u; }
    const size_t kstep = (size_t)(BK * 2);
    const size_t hstepA = (size_t)HALF * g.lda * 2, hstepB = (size_t)HALF * g.ldb * 2;
    const size_t tstepA = 2 * hstepA, tstepB = 2 * hstepB;
    const unsigned ldsw = (unsigned)wid * 1024u;
    const int aoff = lds_byte(wr * 64 + fr, fq * 8), boff = lds_byte(wc * 32 + fr, fq * 8);
#define PG8_SA(b, h) (((b) * 2 + (h)) * HTB)
#define PG8_SB(b, h) ((4 + (b) * 2 + (h)) * HTB)
#define PG8_STAGE(bufoff, gbase, voff) do { _Pragma("unroll") for (int _i = 0; _i < 2; ++_i) \
        __builtin_amdgcn_global_load_lds((const unsigned*)((const char*)(gbase) + (voff)[_i]), (PG8_LAS unsigned*)(lds + (bufoff) + ldsw + _i * 8192), 16, 0, 0); } while (0)
#define PG8_LDA(dst, b, h) do { _Pragma("unroll") for (int m = 0; m < 4; ++m) _Pragma("unroll") for (int k = 0; k < 2; ++k) dst[m][k] = *(const PG8_LAS bf16x8*)(lds + PG8_SA(b, h) + aoff + m * 2048 + k * 1024); } while (0)
#define PG8_LDB(dst, b, h) do { _Pragma("unroll") for (int n = 0; n < 2; ++n) _Pragma("unroll") for (int k = 0; k < 2; ++k) dst[n][k] = *(const PG8_LAS bf16x8*)(lds + PG8_SB(b, h) + boff + n * 2048 + k * 1024); } while (0)
#define PG8_MMA(ai, bj, At, Bt) do { __builtin_amdgcn_s_setprio(1); _Pragma("unroll") for (int m = 0; m < 4; ++m) _Pragma("unroll") for (int n = 0; n < 2; ++n) _Pragma("unroll") for (int k = 0; k < 2; ++k) \
        acc[ai][bj][m][n] = __builtin_amdgcn_mfma_f32_16x16x32_bf16(Bt[n][k], At[m][k], acc[ai][bj][m][n], 0, 0, 0); __builtin_amdgcn_s_setprio(0); } while (0)
#define PG8_WAIT_V(n) asm volatile("s_waitcnt vmcnt(" #n ")" ::: "memory")
#define PG8_WAIT_L(n) asm volatile("s_waitcnt lgkmcnt(" #n ")" ::: "memory")
#define PG8_BAR __builtin_amdgcn_s_barrier()
#define PG8_SCHED __builtin_amdgcn_sched_barrier(0)
    Unit cur, nxt; int ui = 0;
    if (!S.next(0, cur)) return;
    f32x4 acc[2][2][4][2];
#pragma unroll
    for (int a = 0; a < 2; ++a)
#pragma unroll
        for (int b = 0; b < 2; ++b)
#pragma unroll
            for (int m = 0; m < 4; ++m)
#pragma unroll
                for (int n = 0; n < 2; ++n) acc[a][b][m][n] = (f32x4){0.f, 0.f, 0.f, 0.f};
    bf16x8 At[4][2], B0[2][2], B1[2][2];
    const char* cA = (const char*)g.A + (size_t)cur.pm * tstepA + (size_t)cur.ko * 2; const char* cB = (const char*)g.Bt + (size_t)cur.pn * tstepB + (size_t)cur.ko * 2;
    S.a_ready(cur);
    PG8_STAGE(PG8_SB(0, 0), cB, voffB); PG8_STAGE(PG8_SA(0, 0), cA, voffA); PG8_STAGE(PG8_SB(0, 1), cB + hstepB, voffB); PG8_STAGE(PG8_SA(0, 1), cA + hstepA, voffA);
    if (wr == 1) PG8_BAR;
    PG8_WAIT_V(4); PG8_BAR;
    PG8_STAGE(PG8_SB(1, 0), cB + kstep, voffB); PG8_STAGE(PG8_SA(1, 0), cA + kstep, voffA); PG8_STAGE(PG8_SB(1, 1), cB + hstepB + kstep, voffB);
    PG8_WAIT_V(6); PG8_BAR;
    for (;;) {
        const bool has_next = S.next(ui + 1, nxt);
        const char* nA = has_next ? (const char*)g.A + (size_t)nxt.pm * tstepA + (size_t)nxt.ko * 2 : cA; const char* nB = has_next ? (const char*)g.Bt + (size_t)nxt.pn * tstepB + (size_t)nxt.ko * 2 : cB;
        for (int t = 0; t < nt; t += 2) {
            const bool last = (t == nt - 2);
            const char* a1 = cA + (size_t)(t + 1) * kstep;
            const char* a2 = last ? nA : cA + (size_t)(t + 2) * kstep; const char* b2 = last ? nB : cB + (size_t)(t + 2) * kstep;
            const char* a3 = a2 + kstep; const char* b3 = b2 + kstep;
            if (last && has_next) S.a_ready(nxt);
            PG8_LDB(B0, 0, 0); PG8_SCHED; PG8_LDA(At, 0, 0); PG8_STAGE(PG8_SA(1, 1), a1 + hstepA, voffA);
            PG8_WAIT_L(8); PG8_BAR; PG8_WAIT_L(0); PG8_MMA(0, 0, At, B0); PG8_BAR; PG8_SCHED;
            PG8_LDB(B1, 0, 1); PG8_STAGE(PG8_SB(0, 0), b2, voffB);
            PG8_BAR; PG8_WAIT_L(0); PG8_MMA(0, 1, At, B1); PG8_BAR;
            PG8_LDA(At, 0, 1); PG8_STAGE(PG8_SA(0, 0), a2, voffA);
            PG8_BAR; PG8_WAIT_L(0); PG8_MMA(1, 0, At, B0); PG8_BAR; PG8_SCHED;
            PG8_STAGE(PG8_SB(0, 1), b2 + hstepB, voffB);
            PG8_WAIT_V(6); PG8_BAR; PG8_MMA(1, 1, At, B1); PG8_BAR;
            PG8_LDB(B0, 1, 0); PG8_SCHED; PG8_LDA(At, 1, 0); PG8_STAGE(PG8_SA(0, 1), a2 + hstepA, voffA);
            PG8_WAIT_L(8); PG8_BAR; PG8_WAIT_L(0); PG8_MMA(0, 0, At, B0); PG8_BAR; PG8_SCHED;
            PG8_LDB(B1, 1, 1); PG8_STAGE(PG8_SB(1, 0), b3, voffB);
            PG8_BAR; PG8_WAIT_L(0); PG8_MMA(0, 1, At, B1); PG8_BAR;
            PG8_LDA(At, 1, 1); PG8_STAGE(PG8_SA(1, 0), a3, voffA);
            PG8_BAR; PG8_WAIT_L(0); PG8_MMA(1, 0, At, B0); PG8_BAR; PG8_SCHED;
            PG8_STAGE(PG8_SB(1, 1), b3 + hstepB, voffB);
            PG8_WAIT_V(6); PG8_BAR; PG8_MMA(1, 1, At, B1); PG8_BAR;
        }
        E(acc, cur, wr, wc, fr, fq); S.done(cur);
        if (!has_next) break;
#pragma unroll
        for (int a = 0; a < 2; ++a)
#pragma unroll
            for (int b = 0; b < 2; ++b)
#pragma unroll
                for (int m = 0; m < 4; ++m)
#pragma unroll
                    for (int n = 0; n < 2; ++n) acc[a][b][m][n] = (f32x4){0.f, 0.f, 0.f, 0.f};
        cur = nxt; cA = nA; cB = nB; ++ui;
    }
    PG8_WAIT_V(0);
    if (wr == 0) PG8_BAR;
    PG8_BAR;
#undef PG8_SA
#undef PG8_SB
#undef PG8_STAGE
#undef PG8_LDA
#undef PG8_LDB
#undef PG8_MMA
#undef PG8_WAIT_V
#undef PG8_WAIT_L
#undef PG8_BAR
#undef PG8_SCHED
}
}

DI void transpose_item(const float* __restrict__ src, int ldn, bf16_t* __restrict__ dst, int K, int n0, int k0, unsigned char* lds) {
    const int t = tidx();
    unsigned* T = (unsigned*)lds;
    float4 va[4], vb[4];
#pragma unroll
    for (int i = 0; i < 4; ++i) { const int idx = t + 512 * i, n4 = idx & 15, kp = idx >> 4;
        const float* p = src + (size_t)(k0 + 2 * kp) * ldn + n0 + 4 * n4;
        va[i] = *(const float4*)p; vb[i] = *(const float4*)(p + ldn); }
#pragma unroll
    for (int i = 0; i < 4; ++i) { const int idx = t + 512 * i, n4 = idx & 15, kp = idx >> 4;
        T[(4 * n4 + 0) * 130 + kp] = cvt_pk_bf16(va[i].x, vb[i].x);
        T[(4 * n4 + 1) * 130 + kp] = cvt_pk_bf16(va[i].y, vb[i].y);
        T[(4 * n4 + 2) * 130 + kp] = cvt_pk_bf16(va[i].z, vb[i].z);
        T[(4 * n4 + 3) * 130 + kp] = cvt_pk_bf16(va[i].w, vb[i].w); }
    __syncthreads();
#pragma unroll
    for (int i = 0; i < 8; ++i) { const int idx = t + 512 * i, n = idx >> 6, k4 = idx & 63;
        const u32x2 v = *(const u32x2*)(lds + n * 520 + k4 * 8);
        *(u32x2*)(dst + (size_t)(n0 + n) * K + k0 + 4 * k4) = v; }
    __syncthreads();
}

DI void ada_item(const Params& p, int slab, unsigned char* lds) {
    const int t = tidx(), lane = t & 63, w = __builtin_amdgcn_readfirstlane(t >> 6);
    bf16_t* As = (bf16_t*)lds;
    bf16_t* Bs = (bf16_t*)(lds + 160 * 144);
    const int n0 = slab * 64;
    const float* wa = p.in[9];
    const float* cp = p.in[2]; const float* cs = p.in[3];
    float* MOD = (float*)(p.ws + OFF_MOD);
    f32x16 acc0, acc1;
#pragma unroll
    for (int r = 0; r < 16; ++r) { acc0[r] = 0.f; acc1[r] = 0.f; }
    const int mt0 = w % 5, nt0 = w / 5, mt1 = (w + 8) % 5, nt1 = (w + 8) / 5;
    float4 ca[5], wb[2];
#pragma unroll
    for (int i = 0; i < 5; ++i) { const int idx = t + 512 * i, m = idx >> 4, k4 = idx & 15;
        const float* cr = m < 4 ? cp + (size_t)m * D : cs + (size_t)(m - 4) * D;
        ca[i] = m < 132 ? *(const float4*)(cr + 4 * k4) : make_float4(0.f, 0.f, 0.f, 0.f); }
#pragma unroll
    for (int i = 0; i < 2; ++i) { const int idx = t + 512 * i, k = idx >> 4, n4 = idx & 15;
        wb[i] = *(const float4*)(wa + (size_t)k * 12288 + n0 + 4 * n4); }
    for (int kc = 0; kc < 32; ++kc) {
#pragma unroll
        for (int i = 0; i < 5; ++i) { const int idx = t + 512 * i, m = idx >> 4, k4 = idx & 15;
            u32x2 v; v.x = cvt_pk_bf16(siluf_(ca[i].x), siluf_(ca[i].y)); v.y = cvt_pk_bf16(siluf_(ca[i].z), siluf_(ca[i].w));
            *(u32x2*)(As + m * 72 + 4 * k4) = v; }
#pragma unroll
        for (int i = 0; i < 2; ++i) { const int idx = t + 512 * i, k = idx >> 4, n4 = idx & 15;
            Bs[(4 * n4 + 0) * 72 + k] = f2bf(wb[i].x); Bs[(4 * n4 + 1) * 72 + k] = f2bf(wb[i].y);
            Bs[(4 * n4 + 2) * 72 + k] = f2bf(wb[i].z); Bs[(4 * n4 + 3) * 72 + k] = f2bf(wb[i].w); }
        __syncthreads();
        if (kc + 1 < 32) {
            const int kb = (kc + 1) * 64;
#pragma unroll
            for (int i = 0; i < 5; ++i) { const int idx = t + 512 * i, m = idx >> 4, k4 = idx & 15;
                const float* cr = m < 4 ? cp + (size_t)m * D : cs + (size_t)(m - 4) * D;
                ca[i] = m < 132 ? *(const float4*)(cr + kb + 4 * k4) : make_float4(0.f, 0.f, 0.f, 0.f); }
#pragma unroll
            for (int i = 0; i < 2; ++i) { const int idx = t + 512 * i, k = idx >> 4, n4 = idx & 15;
                wb[i] = *(const float4*)(wa + (size_t)(kb + k) * 12288 + n0 + 4 * n4); }
        }
#pragma unroll
        for (int ks = 0; ks < 4; ++ks) {
            const int ko = ks * 16 + 8 * (lane >> 5);
            const bf16x8 a0 = *(const bf16x8*)(As + (mt0 * 32 + (lane & 31)) * 72 + ko);
            const bf16x8 b0 = *(const bf16x8*)(Bs + (nt0 * 32 + (lane & 31)) * 72 + ko);
            acc0 = MFMA32(a0, b0, acc0);
            if (w < 2) {
                const bf16x8 a1 = *(const bf16x8*)(As + (mt1 * 32 + (lane & 31)) * 72 + ko);
                const bf16x8 b1 = *(const bf16x8*)(Bs + (nt1 * 32 + (lane & 31)) * 72 + ko);
                acc1 = MFMA32(a1, b1, acc1);
            }
        }
        __syncthreads();
    }
    const float* ba = p.in[10];
    {
        const int n = n0 + nt0 * 32 + (lane & 31); const float bv = ba[n];
#pragma unroll
        for (int r = 0; r < 16; ++r) { const int m = mt0 * 32 + crow(r, lane >> 5); if (m < 132) MOD[(size_t)m * 12288 + n] = acc0[r] + bv; }
    }
    if (w < 2) {
        const int n = n0 + nt1 * 32 + (lane & 31); const float bv = ba[n];
#pragma unroll
        for (int r = 0; r < 16; ++r) { const int m = mt1 * 32 + crow(r, lane >> 5); if (m < 132) MOD[(size_t)m * 12288 + n] = acc1[r] + bv; }
    }
}

DI void tr_w_in(const Params& p, int it, unsigned char* lds) { transpose_item(p.in[11], INC, (bf16_t*)(p.ws + OFF_WT_IN), D, (it >> 3) * 64, (it & 7) * 256, lds); }
DI void tr_w_out(const Params& p, int it, unsigned char* lds) { transpose_item(p.in[15], D, (bf16_t*)(p.ws + OFF_WT_OUT), D, (it >> 3) * 64, (it & 7) * 256, lds); }
DI void tr_w_up(const Params& p, int it, unsigned char* lds) { transpose_item(p.in[18], NUP, (bf16_t*)(p.ws + OFF_WT_UP), D, (it >> 3) * 64, (it & 7) * 256, lds); }
DI void tr_w_down(const Params& p, int it, unsigned char* lds) { transpose_item(p.in[20], D, (bf16_t*)(p.ws + OFF_WT_DOWN), DFF, (it / 22) * 64, (it % 22) * 256, lds); }
DI void phase0(const Params& p, unsigned char* lds, int ctr_off) {
    unsigned* ctr = (unsigned*)(p.ws + OFF_CTL) + ctr_off;
    for (;;) {
        int it = next_item(ctr, lds);
        if (it >= 192 + 896 + 704) break;
        if (it < 192) { ada_item(p, it, lds); continue; }
        it -= 192;
        if (it < 896) { tr_w_in(p, it, lds); continue; }
        it -= 896;
        tr_w_up(p, it, lds);
    }
}
DI void phase2_idle(const Params& p, unsigned char* lds, int ctr_off) {
    unsigned* ctr = (unsigned*)(p.ws + OFF_CTL) + ctr_off;
    for (;;) { const int it = next_item(ctr, lds); if (it >= 704) break; tr_w_down(p, it, lds); }
}

DI int mod_row(int row) { return row < MP ? (row >> 11) : 4 + ((row - MP) >> 2); }
DI void phase1(const Params& p, unsigned char* lds) {
    const int t = tidx(), lane = t & 63, w = t >> 6;
    float* wg = (float*)lds;
    const float* w_in = p.in[11];
#pragma unroll
    for (int i = 0; i < 8; ++i) { const int idx = t + 512 * i, c = idx >> 1, hf = idx & 1;
        const float4 v = *(const float4*)(w_in + (size_t)c * INC + NP + 4 * hf);
        wg[(4 * hf + 0) * 2048 + c] = v.x; wg[(4 * hf + 1) * 2048 + c] = v.y; wg[(4 * hf + 2) * 2048 + c] = v.z; wg[(4 * hf + 3) * 2048 + c] = v.w; }
    __syncthreads();
    const float* bgate = p.in[12];
    const float* MOD = (const float*)(p.ws + OFF_MOD);
    bf16_t* U = (bf16_t*)(p.ws + OFF_U);
    float* LG = (float*)(p.ws + OFF_LG);
    for (int row = blockIdx.x * 8 + w; row < M; row += gridDim.x * 8) {
        const float* xr = row < MP ? p.in[0] + (size_t)row * D : p.in[1] + (size_t)(row - MP) * D;
        const float* mod = MOD + (size_t)mod_row(row) * 12288;
        float4 xv[8];
        float s = 0.f;
#pragma unroll
        for (int i = 0; i < 8; ++i) { xv[i] = *(const float4*)(xr + (i * 64 + lane) * 4); s += (xv[i].x + xv[i].y) + (xv[i].z + xv[i].w); }
        const float mu = wave_sum(s) * (1.0f / 2048.0f);
        float q = 0.f;
#pragma unroll
        for (int i = 0; i < 8; ++i) { const float a = xv[i].x - mu, b = xv[i].y - mu, c = xv[i].z - mu, d = xv[i].w - mu; q += (a * a + b * b) + (c * c + d * d); }
        const float rstd = rsqrtf(wave_sum(q) * (1.0f / 2048.0f) + LN_EPS);
        float g[8];
#pragma unroll
        for (int j = 0; j < 8; ++j) g[j] = 0.f;
#pragma unroll
        for (int i = 0; i < 8; ++i) {
            const int c = (i * 64 + lane) * 4;
            const float4 sh = *(const float4*)(mod + c), sc = *(const float4*)(mod + 2048 + c);
            float4 u;
            u.x = (xv[i].x - mu) * rstd * (1.0f + sc.x) + sh.x; u.y = (xv[i].y - mu) * rstd * (1.0f + sc.y) + sh.y;
            u.z = (xv[i].z - mu) * rstd * (1.0f + sc.z) + sh.z; u.w = (xv[i].w - mu) * rstd * (1.0f + sc.w) + sh.w;
            u32x2 o; o.x = cvt_pk_bf16(u.x, u.y); o.y = cvt_pk_bf16(u.z, u.w);
            *(u32x2*)(U + (size_t)row * D + c) = o;
#pragma unroll
            for (int j = 0; j < 8; ++j) { const float4 wv = *(const float4*)(wg + j * 2048 + c); g[j] += (u.x * wv.x + u.y * wv.y) + (u.z * wv.z + u.w * wv.w); }
            __builtin_amdgcn_sched_barrier(0);
        }
#pragma unroll
        for (int j = 0; j < 8; ++j) g[j] = wave_sum(g[j]);
        float gj = g[0];
#pragma unroll
        for (int j = 1; j < 8; ++j) gj = (lane == j) ? g[j] : gj;
        if (lane < 8) {
            float val = gj + bgate[lane];
            if (lane >= 4) val = fminf(val, 0.f) - log1pf(__expf(-fabsf(val)));
            LG[(size_t)row * 8 + lane] = val;
        }
    }
}

DI void conv_item(const Params& p, int item) {
    const int t = tidx();
    const int c8 = (t & 127) * 8, rq = t >> 7;
    const bf16_t* P = (const bf16_t*)(p.ws + OFF_P);
    bf16_t* MIXIN = (bf16_t*)(p.ws + OFF_MIXIN);
    const float* wconv = p.in[13];
    float w0[8], w1[8], w2[8];
#pragma unroll
    for (int j = 0; j < 8; ++j) { w0[j] = wconv[c8 + j]; w1[j] = wconv[1024 + c8 + j]; w2[j] = wconv[2048 + c8 + j]; }
    if (item < 128) {
        const int row0 = item * 64 + rq * 16, tp0 = row0 & 2047;
        float zm2[8], zm1[8];
        if (tp0 == 0) {
#pragma unroll
            for (int e = 0; e < 8; ++e) { zm2[e] = 0.f; zm1[e] = 0.f; }
        } else {
            float a[8], h[8];
            const bf16_t* pr = P + (size_t)(row0 - 2) * NP;
            unpack8(*(const u32x4*)(pr + 1024 + c8), a); unpack8(*(const u32x4*)(pr + 2048 + c8), h);
#pragma unroll
            for (int e = 0; e < 8; ++e) zm2[e] = a[e] * h[e];
            unpack8(*(const u32x4*)(pr + NP + 1024 + c8), a); unpack8(*(const u32x4*)(pr + NP + 2048 + c8), h);
#pragma unroll
            for (int e = 0; e < 8; ++e) zm1[e] = a[e] * h[e];
        }
        for (int q = 0; q < 16; q += 4) {
            u32x4 av[4], hv[4], bv[4];
#pragma unroll
            for (int k = 0; k < 4; ++k) { const bf16_t* pr = P + (size_t)(row0 + q + k) * NP + c8; bv[k] = *(const u32x4*)pr; av[k] = *(const u32x4*)(pr + 1024); hv[k] = *(const u32x4*)(pr + 2048); }
#pragma unroll
            for (int k = 0; k < 4; ++k) {
                float a[8], h[8], bg[8], z[8], y[8];
                unpack8(av[k], a); unpack8(hv[k], h); unpack8(bv[k], bg);
#pragma unroll
                for (int e = 0; e < 8; ++e) { z[e] = a[e] * h[e]; y[e] = bg[e] * (w0[e] * zm2[e] + w1[e] * zm1[e] + w2[e] * z[e]); }
                *(u32x4*)(MIXIN + (size_t)(row0 + q + k) * D + c8) = pack8(y);
#pragma unroll
                for (int e = 0; e < 8; ++e) { zm2[e] = zm1[e]; zm1[e] = z[e]; }
            }
        }
        if (tp0 + 16 == 2048) {
            float* o = p.out + O_PCONV + (size_t)((row0 >> 11) * 2) * 1024 + c8;
            *(float4*)(o) = make_float4(zm2[0], zm2[1], zm2[2], zm2[3]); *(float4*)(o + 4) = make_float4(zm2[4], zm2[5], zm2[6], zm2[7]);
            *(float4*)(o + 1024) = make_float4(zm1[0], zm1[1], zm1[2], zm1[3]); *(float4*)(o + 1028) = make_float4(zm1[4], zm1[5], zm1[6], zm1[7]);
        }
        return;
    }
    for (int it = 0; it < 16; ++it) {
        const int rr = (item - 128) * 64 + it * 4 + rq, row = MP + rr;
        const int b = rr >> 2, tp = rr & 3;
        float z[3][8];
#pragma unroll
        for (int j = 0; j < 3; ++j) {
            const int tq = tp - 2 + j;
            if (tq >= 0) {
                const bf16_t* pr = P + (size_t)(row - 2 + j) * NP;
                float a[8], h[8];
                unpack8(*(const u32x4*)(pr + 1024 + c8), a); unpack8(*(const u32x4*)(pr + 2048 + c8), h);
#pragma unroll
                for (int e = 0; e < 8; ++e) z[j][e] = a[e] * h[e];
            } else {
                const float* sp = p.in[4] + (size_t)(b * 2 + tq + 2) * 1024 + c8;
                const float4 s0 = *(const float4*)sp, s1 = *(const float4*)(sp + 4);
                z[j][0] = s0.x; z[j][1] = s0.y; z[j][2] = s0.z; z[j][3] = s0.w; z[j][4] = s1.x; z[j][5] = s1.y; z[j][6] = s1.z; z[j][7] = s1.w;
            }
        }
        float bgv[8], y[8];
        unpack8(*(const u32x4*)(P + (size_t)row * NP + c8), bgv);
#pragma unroll
        for (int e = 0; e < 8; ++e) y[e] = bgv[e] * (w0[e] * z[0][e] + w1[e] * z[1][e] + w2[e] * z[2][e]);
        *(u32x4*)(MIXIN + (size_t)row * D + c8) = pack8(y);
        if (tp == 3) {
            float* o = p.out + O_SCONV + (size_t)(b * 2) * 1024 + c8;
            *(float4*)(o) = make_float4(z[1][0], z[1][1], z[1][2], z[1][3]); *(float4*)(o + 4) = make_float4(z[1][4], z[1][5], z[1][6], z[1][7]);
            *(float4*)(o + 1024) = make_float4(z[2][0], z[2][1], z[2][2], z[2][3]); *(float4*)(o + 1028) = make_float4(z[2][4], z[2][5], z[2][6], z[2][7]);
        }
    }
}

DI void mlstm_sample_item(const Params& p, int bh, unsigned char* lds) {
    const int t = tidx(), lane = t & 63, w = t >> 6;
    const int b = bh >> 2, hh = bh & 3, r0 = MP + b * 4;
    const bf16_t* P = (const bf16_t*)(p.ws + OFF_P);
    const float* LG = (const float*)(p.ws + OFF_LG);
    bf16_t* HRAW = (bf16_t*)(p.ws + OFF_HRAW);
    float* qS = (float*)lds; float* kS = qS + 1024; float* vS = kS + 1024; float* kwS = vS + 1024; float* nS = kwS + 1024;
    float* sc = nS + 256; float* dots = sc + 64; float* part = dots + 32;
#pragma unroll
    for (int i = 0; i < 6; ++i) { const int idx = t + 512 * i, arr = idx >> 10, rem = idx & 1023, tt = rem >> 8, d = rem & 255;
        float v = bf2f(P[(size_t)(r0 + tt) * NP + 3072 + arr * 1024 + hh * 256 + d]);
        if (arr == 1) v *= 0.0625f;
        qS[idx] = v; }
    if (t < 256) nS[t] = p.in[6][(size_t)bh * 256 + t];
    if (t == 0) {
        float li[4], lf[4], bb[4], aa[4], mt[4];
        const float m0 = p.in[7][bh];
#pragma unroll
        for (int i = 0; i < 4; ++i) { li[i] = LG[(size_t)(r0 + i) * 8 + hh]; lf[i] = LG[(size_t)(r0 + i) * 8 + 4 + hh]; }
        bb[0] = lf[0]; bb[1] = bb[0] + lf[1]; bb[2] = bb[1] + lf[2]; bb[3] = bb[2] + lf[3];
#pragma unroll
        for (int i = 0; i < 4; ++i) {
            aa[i] = bb[i] + m0; float m = aa[i];
#pragma unroll
            for (int s = 0; s < 4; ++s) if (s <= i) m = fmaxf(m, bb[i] - bb[s] + li[s]);
            mt[i] = m;
            sc[i] = __expf(aa[i] - m); sc[4 + i] = __expf(-m);
#pragma unroll
            for (int s = 0; s < 4; ++s) sc[16 + i * 4 + s] = (s <= i) ? __expf(bb[i] - bb[s] + li[s] - m) : 0.f;
        }
#pragma unroll
        for (int s = 0; s < 4; ++s) sc[8 + s] = __expf(bb[3] - bb[s] + li[s] - mt[3]);
        sc[12] = __expf(aa[3] - mt[3]); sc[13] = mt[3];
    }
    __syncthreads();
#pragma unroll
    for (int i = 0; i < 3; ++i) { const int pd = w + 8 * i;
        if (pd < 20) {
            const float* qa = qS + (pd < 16 ? (pd >> 2) : (pd - 16)) * 256 + lane * 4;
            const float* kb = (pd < 16 ? kS + (pd & 3) * 256 : nS) + lane * 4;
            const float4 x = *(const float4*)qa, y = *(const float4*)kb;
            const float sum = wave_sum((x.x * y.x + x.y * y.y) + (x.z * y.z + x.w * y.w));
            if (lane == 0) dots[pd] = sum;
        } }
#pragma unroll
    for (int i = 0; i < 2; ++i) { const int idx = t + 512 * i; kwS[idx] = sc[8 + (idx >> 8)] * kS[idx]; }
    __syncthreads();
    if (t < 4) {
        float den = 0.f;
#pragma unroll
        for (int s = 0; s < 4; ++s) { const float sp = dots[t * 4 + s] * sc[16 + t * 4 + s]; sc[32 + t * 4 + s] = sp; den += sp; }
        den += sc[t] * dots[16 + t];
        sc[48 + t] = fmaxf(fabsf(den), sc[4 + t]);
    }
    {
        const int e4 = lane, dg = w;
        const float dc = sc[12];
        float4 vv[4];
#pragma unroll
        for (int s = 0; s < 4; ++s) vv[s] = *(const float4*)(vS + s * 256 + 4 * e4);
        float4 acc[4];
#pragma unroll
        for (int tt = 0; tt < 4; ++tt) acc[tt] = make_float4(0.f, 0.f, 0.f, 0.f);
        const float* C0 = p.in[5] + (size_t)bh * 65536 + 4 * e4;
        float* C1 = p.out + O_SC + (size_t)bh * 65536 + 4 * e4;
        for (int i0 = 0; i0 < 32; i0 += 8) {
            float4 cv[8];
#pragma unroll
            for (int u = 0; u < 8; ++u) cv[u] = *(const float4*)(C0 + (size_t)(dg + 8 * (i0 + u)) * 256);
#pragma unroll
            for (int u = 0; u < 8; ++u) {
                const int d = dg + 8 * (i0 + u);
                const float4 c = cv[u];
                float4 cn = make_float4(dc * c.x, dc * c.y, dc * c.z, dc * c.w);
#pragma unroll
                for (int tt = 0; tt < 4; ++tt) { const float qv = qS[tt * 256 + d];
                    acc[tt].x += qv * c.x; acc[tt].y += qv * c.y; acc[tt].z += qv * c.z; acc[tt].w += qv * c.w; }
#pragma unroll
                for (int s = 0; s < 4; ++s) { const float kv = kwS[s * 256 + d];
                    cn.x += kv * vv[s].x; cn.y += kv * vv[s].y; cn.z += kv * vv[s].z; cn.w += kv * vv[s].w; }
                *(float4*)(C1 + (size_t)d * 256) = cn;
            }
        }
#pragma unroll
        for (int tt = 0; tt < 4; ++tt) *(float4*)(part + (dg * 4 + tt) * 256 + 4 * e4) = acc[tt];
    }
    __syncthreads();
#pragma unroll
    for (int i = 0; i < 2; ++i) { const int idx = t + 512 * i, tt = idx >> 8, e = idx & 255;
        float qc = 0.f;
#pragma unroll
        for (int g = 0; g < 8; ++g) qc += part[(g * 4 + tt) * 256 + e];
        float num = sc[tt] * qc;
#pragma unroll
        for (int s = 0; s < 4; ++s) num += sc[32 + tt * 4 + s] * vS[s * 256 + e];
        HRAW[(size_t)(r0 + tt) * 1024 + hh * 256 + e] = f2bf(num / sc[48 + tt]);
    }
    if (t < 256) {
        float nn = sc[12] * nS[t];
#pragma unroll
        for (int s = 0; s < 4; ++s) nn += kwS[s * 256 + t];
        p.out[O_SN + (size_t)bh * 256 + t] = nn;
    }
    if (t == 0) p.out[O_SM + bh] = sc[13];
}

#define LBAR() do { asm volatile("s_waitcnt lgkmcnt(0)" ::: "memory"); __builtin_amdgcn_s_barrier(); asm volatile("" ::: "memory"); } while (0)
DI void mlstm_prompt_item(const Params& p, int item, unsigned char* lds) {
    const int t = tidx(), lane = t & 63, w = __builtin_amdgcn_readfirstlane(t >> 6);
    const int l31 = lane & 31, lh = lane >> 5;
    const int bh = item >> 3, es = item & 7, b = bh >> 2, hh = bh & 3;
    const bf16_t* P = (const bf16_t*)(p.ws + OFF_P);
    const float* LG = (const float*)(p.ws + OFF_LG);
    bf16_t* HRAW = (bf16_t*)(p.ws + OFF_HRAW);
    bf16_t* Qs = (bf16_t*)(lds);
    bf16_t* Ks0 = (bf16_t*)(lds + 33792);
    bf16_t* Vs0 = (bf16_t*)(lds + 101376);
    bf16_t* Ss = (bf16_t*)(lds + 111616);
    bf16_t* CTs = (bf16_t*)(lds + 120832);
    float* nS = (float*)(lds + 137728);
    float* sc0 = (float*)(lds + 138752);
    float* qnS = (float*)(lds + 141824);
    typedef short s16x4 __attribute__((ext_vector_type(4)));
    typedef __attribute__((address_space(3))) s16x4* lds_s16x4_p;
    const int trq = (lane & 15) >> 2, trc = 16 * ((lane >> 4) & 1) + 4 * (lane & 3);
#define TRFRAG(dst, img, pitch, k0, c0) do { \
        const s16x4 lo_ = __builtin_amdgcn_ds_read_tr16_b64_v4i16((lds_s16x4_p)((img) + ((k0) + 8 * lh + trq) * (pitch) + (c0) + trc)); \
        const s16x4 hi_ = __builtin_amdgcn_ds_read_tr16_b64_v4i16((lds_s16x4_p)((img) + ((k0) + 8 * lh + 4 + trq) * (pitch) + (c0) + trc)); \
        dst[0] = lo_[0]; dst[1] = lo_[1]; dst[2] = lo_[2]; dst[3] = lo_[3]; dst[4] = hi_[0]; dst[5] = hi_[1]; dst[6] = hi_[2]; dst[7] = hi_[3]; } while (0)
    for (int i = t; i < 16896 / 4; i += 512) ((unsigned*)CTs)[i] = 0u;
    if (t < 256) nS[t] = 0.f;
    f32x16 Cacc, accN, acc2;
#pragma unroll
    for (int r = 0; r < 16; ++r) { Cacc[r] = 0.f; accN[r] = 0.f; acc2[r] = 0.f; }
    float m_prev = 0.f;
    u32x4 qr[4], kr[4], vr; float li = 0.f, lf = 0.f;
    vr = (u32x4){0u, 0u, 0u, 0u};
    const size_t rbase = (size_t)b * 2048;
#define LOADCHUNK(j) do { const size_t r0_ = rbase + (size_t)(j) * 64; int tl_ = t; asm volatile("" : "+v"(tl_)); \
    _Pragma("unroll") for (int i = 0; i < 4; ++i) { const int idx = tl_ + 512 * i; \
        qr[i] = *(const u32x4*)(P + (r0_ + (idx >> 5)) * NP + 3072 + hh * 256 + 8 * (idx & 31)); \
        kr[i] = *(const u32x4*)(P + (r0_ + (idx >> 5)) * NP + 4096 + hh * 256 + 8 * (idx & 31)); } \
    if (t < 256) vr = *(const u32x4*)(P + (r0_ + (tl_ >> 2)) * NP + 5120 + hh * 256 + es * 32 + 8 * (tl_ & 3)); \
    if (w == 7) { li = LG[(r0_ + lane) * 8 + hh]; lf = LG[(r0_ + lane) * 8 + 4 + hh]; } } while (0)
    LOADCHUNK(0);
    bf16x8 ones;
#pragma unroll
    for (int j = 0; j < 8; ++j) ones[j] = (short)0x3F80;
#define STAGE_CHUNK(jn) do { bf16_t* const Kn = Ks0 + ((jn) & 1) * 16896; bf16_t* const Vn = Vs0 + ((jn) & 1) * 2560; float* const scn = sc0 + ((jn) & 1) * 384; \
        int ta = t; asm volatile("" : "+v"(ta)); \
        _Pragma("unroll") \
        for (int i = 0; i < 4; ++i) { const int idx = ta + 512 * i; \
            *(u32x4*)(Qs + (idx >> 5) * 264 + 8 * (idx & 31)) = qr[i]; \
            *(u32x4*)(Kn + (idx >> 5) * 264 + 8 * (idx & 31)) = kr[i]; } \
        if (t < 256) *(u32x4*)(Vn + (ta >> 2) * 40 + 8 * (ta & 3)) = vr; \
        if (w == 7) { \
            float bs = lf; \
        _Pragma("unroll") \
            for (int o = 1; o < 64; o <<= 1) { const float n = __shfl_up(bs, o); if (lane >= o) bs += n; } \
            const float g = li - bs; \
            float gm = g; \
        _Pragma("unroll") \
            for (int o = 1; o < 64; o <<= 1) { const float n = __shfl_up(gm, o); if (lane >= o) gm = fmaxf(gm, n); } \
            const float mx = fmaxf(m_prev, gm); \
            const float mt = bs + mx, rw = -mx; \
            const float inter = __expf(rw + m_prev); \
            const float row63 = __shfl(rw, 63); \
            const float g16 = g - 2.772588722239781f; \
            scn[lane] = __expf(rw); scn[64 + lane] = __expf(g16); scn[128 + lane] = inter; scn[192 + lane] = __expf(-mt); scn[256 + lane] = __expf(g16 + row63); \
            m_prev = __shfl(mt, 63); \
        } } while (0)
    STAGE_CHUNK(0);
    for (int j = 0; j < 32; ++j) {
        bf16_t* const Ks = Ks0 + (j & 1) * 16896; bf16_t* const Vs = Vs0 + (j & 1) * 2560;
        float* const rowS = sc0 + (j & 1) * 384; float* const colS = rowS + 64; float* const interS = rowS + 128; float* const emtS = rowS + 192; float* const wcS = rowS + 256;
        LBAR();
        if (j + 1 < 32) LOADCHUNK(j + 1);
        if (w < 4) {
            const int tb = w >> 1, sb = w & 1;
            f32x16 acc;
#pragma unroll
            for (int r = 0; r < 16; ++r) acc[r] = 0.f;
            if (sb <= tb) {
#pragma unroll 4
                for (int ks = 0; ks < 16; ++ks) {
                    const bf16x8 a = *(const bf16x8*)(Qs + (tb * 32 + l31) * 264 + ks * 16 + 8 * lh);
                    const bf16x8 bq = *(const bf16x8*)(Ks + (sb * 32 + l31) * 264 + ks * 16 + 8 * lh);
                    acc = MFMA32(a, bq, acc);
                }
            }
            const int s = sb * 32 + l31; const float cs = colS[s];
#pragma unroll
            for (int r = 0; r < 16; ++r) { const int tr = tb * 32 + crow(r, lh);
                const float val = (s <= tr) ? acc[r] * (rowS[tr] * cs) : 0.f;
                Ss[tr * 72 + s] = f2bf(val); }
        } else if (w < 6) {
            const int tb = w - 4;
#pragma unroll
            for (int r = 0; r < 16; ++r) acc2[r] = 0.f;
#pragma unroll 4
            for (int ks = 0; ks < 16; ++ks) {
                const bf16x8 a = *(const bf16x8*)(Qs + (tb * 32 + l31) * 264 + ks * 16 + 8 * lh);
                const bf16x8 bc = *(const bf16x8*)(CTs + l31 * 264 + ks * 16 + 8 * lh);
                acc2 = MFMA32(a, bc, acc2);
            }
        } else {
            const int tb = w - 6;
            f32x16 accq;
#pragma unroll
            for (int r = 0; r < 16; ++r) accq[r] = 0.f;
#pragma unroll 4
            for (int ks = 0; ks < 16; ++ks) {
                const bf16x8 a = *(const bf16x8*)(Qs + (tb * 32 + l31) * 264 + ks * 16 + 8 * lh);
                const float4 n0 = *(const float4*)(nS + ks * 16 + 8 * lh), n1 = *(const float4*)(nS + ks * 16 + 8 * lh + 4);
                u32x4 nb; nb.x = cvt_pk_bf16(n0.x, n0.y); nb.y = cvt_pk_bf16(n0.z, n0.w); nb.z = cvt_pk_bf16(n1.x, n1.y); nb.w = cvt_pk_bf16(n1.z, n1.w);
                if (l31 != 0) nb = (u32x4){0u, 0u, 0u, 0u};
                accq = MFMA32(a, __builtin_bit_cast(bf16x8, nb), accq);
            }
            if (l31 == 0) {
#pragma unroll
                for (int r = 0; r < 16; ++r) qnS[tb * 32 + crow(r, lh)] = accq[r];
            }
        }
        LBAR();
        if (w == 4 || w == 5) {
            const int tb = w - 4;
            f32x16 accS, accD;
#pragma unroll
            for (int r = 0; r < 16; ++r) { accS[r] = 0.f; accD[r] = 0.f; }
#pragma unroll
            for (int ks = 0; ks < 4; ++ks) {
                const bf16x8 a = *(const bf16x8*)(Ss + (tb * 32 + l31) * 72 + ks * 16 + 8 * lh);
                bf16x8 bv; TRFRAG(bv, Vs, 40, ks * 16, 0);
                accS = MFMA32(a, bv, accS);
                accD = MFMA32(a, ones, accD);
            }
            const size_t r0 = rbase + (size_t)j * 64;
#pragma unroll
            for (int r = 0; r < 16; ++r) { const int tr = tb * 32 + crow(r, lh);
                const float it = interS[tr];
                const float den = accD[r] + it * qnS[tr];
                const float dn = fmaxf(fabsf(den), emtS[tr]);
                const float hv = (accS[r] + it * acc2[r]) * __builtin_amdgcn_rcpf(dn);
                HRAW[(r0 + tr) * 1024 + hh * 256 + es * 32 + l31] = f2bf(hv); }
        }
        {
            const float dc = interS[63];
#pragma unroll
            for (int r = 0; r < 16; ++r) { Cacc[r] *= dc; accN[r] *= dc; }
#pragma unroll
            for (int ks = 0; ks < 4; ++ks) {
                bf16x8 kt; TRFRAG(kt, Ks, 264, ks * 16, w * 32);
                bf16x8 vt; TRFRAG(vt, Vs, 40, ks * 16, 0);
                float vf[8]; unpack8(__builtin_bit_cast(u32x4, vt), vf);
                const float4 wa = *(const float4*)(wcS + ks * 16 + 8 * lh), wb = *(const float4*)(wcS + ks * 16 + 8 * lh + 4);
                vf[0] *= wa.x; vf[1] *= wa.y; vf[2] *= wa.z; vf[3] *= wa.w; vf[4] *= wb.x; vf[5] *= wb.y; vf[6] *= wb.z; vf[7] *= wb.w;
                const u32x4 pk = pack8(vf);
                Cacc = MFMA32(kt, __builtin_bit_cast(bf16x8, pk), Cacc);
                u32x4 nb; nb.x = cvt_pk_bf16(wa.x, wa.y); nb.y = cvt_pk_bf16(wa.z, wa.w); nb.z = cvt_pk_bf16(wb.x, wb.y); nb.w = cvt_pk_bf16(wb.z, wb.w);
                if (l31 != 0) nb = (u32x4){0u, 0u, 0u, 0u};
                accN = MFMA32(kt, __builtin_bit_cast(bf16x8, nb), accN);
            }
#pragma unroll
            for (int g = 0; g < 4; ++g) { u32x2 o; o.x = cvt_pk_bf16(Cacc[4 * g], Cacc[4 * g + 1]); o.y = cvt_pk_bf16(Cacc[4 * g + 2], Cacc[4 * g + 3]);
                *(u32x2*)(CTs + l31 * 264 + w * 32 + 8 * g + 4 * lh) = o; }
            if (l31 == 0) {
#pragma unroll
                for (int r = 0; r < 16; ++r) nS[w * 32 + crow(r, lh)] = accN[r];
            }
        }
        if (j + 1 < 32) STAGE_CHUNK(j + 1);
    }
    LBAR();
#undef STAGE_CHUNK
#undef LOADCHUNK
#undef TRFRAG
    {
        float* oc = p.out + O_PC + (size_t)bh * 65536 + es * 32 + l31;
#pragma unroll
        for (int r = 0; r < 16; ++r) oc[(size_t)(w * 32 + crow(r, lh)) * 256] = Cacc[r];
        if (es == 0) {
            if (t < 256) p.out[O_PN + (size_t)bh * 256 + t] = nS[t];
            if (w == 7 && lane == 0) p.out[O_PM + bh] = m_prev;
        }
    }
}

DI void phase3(const Params& p, unsigned char* lds, int ctr_off) {
    unsigned* ctr = (unsigned*)(p.ws + OFF_CTL) + ctr_off;
    for (int rep = 0; rep < ((DUPMASK & 4096) ? 2 : 1); ++rep)
    for (int it = blockIdx.x; it < 128; it += gridDim.x) { __syncthreads(); mlstm_prompt_item(p, it, lds); }
    for (;;) {
        const int it = next_item(ctr, lds);
        if (it >= 512 + 136 + 704 + 256) break;
        if (it < 512) mlstm_sample_item(p, it, lds); else if (it < 648) conv_item(p, it - 512); else if (it < 1352) tr_w_up(p, it - 648 + 704, lds); else tr_w_out(p, it - 1352, lds);
    }
}

DI void phase3b(const Params& p) {
    const int t = tidx(), lane = t & 63, w = t >> 6;
    const bf16_t* P = (const bf16_t*)(p.ws + OFF_P);
    const bf16_t* HRAW = (const bf16_t*)(p.ws + OFF_HRAW);
    bf16_t* MIXIN = (bf16_t*)(p.ws + OFF_MIXIN);
    const float* wn = p.in[14];
    const int nw = gridDim.x * 8, total = M * 4;
    for (int it0 = blockIdx.x * 8 + w; it0 < total; it0 += 4 * nw) {
        u32x2 hv[4], ov[4];
#pragma unroll
        for (int k = 0; k < 4; ++k) { const int it = it0 + k * nw < total ? it0 + k * nw : it0; const int row = it >> 2, hh = it & 3;
            hv[k] = *(const u32x2*)(HRAW + (size_t)row * 1024 + hh * 256 + 4 * lane);
            ov[k] = *(const u32x2*)(P + (size_t)row * NP + 6144 + hh * 256 + 4 * lane); }
#pragma unroll
        for (int k = 0; k < 4; ++k) {
            const int it = it0 + k * nw;
            if (it < total) {
                const int row = it >> 2, hh = it & 3;
                const float h0 = bf_lo(hv[k].x), h1 = bf_hi(hv[k].x), h2 = bf_lo(hv[k].y), h3 = bf_hi(hv[k].y);
                const float mu = wave_sum((h0 + h1) + (h2 + h3)) * (1.0f / 256.0f);
                const float a = h0 - mu, b = h1 - mu, c = h2 - mu, d = h3 - mu;
                const float rstd = rsqrtf(wave_sum((a * a + b * b) + (c * c + d * d)) * (1.0f / 256.0f) + LN_EPS);
                const float4 wv = *(const float4*)(wn + hh * 256 + 4 * lane);
                u32x2 o;
                o.x = cvt_pk_bf16(a * rstd * wv.x * sigmoidf_(bf_lo(ov[k].x)), b * rstd * wv.y * sigmoidf_(bf_hi(ov[k].x)));
                o.y = cvt_pk_bf16(c * rstd * wv.z * sigmoidf_(bf_lo(ov[k].y)), d * rstd * wv.w * sigmoidf_(bf_hi(ov[k].y)));
                *(u32x2*)(MIXIN + (size_t)row * D + 1024 + hh * 256 + 4 * lane) = o;
            }
        }
    }
}

DI void phase5(const Params& p) {
    const int t = tidx(), lane = t & 63, w = t >> 6;
    const float* MOD = (const float*)(p.ws + OFF_MOD);
    const bf16_t* MIX = (const bf16_t*)(p.ws + OFF_MIX);
    const float* PO = (const float*)(p.ws + OFF_PART_OUT);
    bf16_t* X1 = (bf16_t*)(p.ws + OFF_X1);
    bf16_t* U = (bf16_t*)(p.ws + OFF_U);
    const float* lg = p.in[16]; const float* lb = p.in[17];
    for (int row = blockIdx.x * 8 + w; row < M; row += gridDim.x * 8) {
        const float* xr = row < MP ? p.in[0] + (size_t)row * D : p.in[1] + (size_t)(row - MP) * D;
        const float* mod = MOD + (size_t)mod_row(row) * 12288;
        const bf16_t* mr = MIX + (size_t)row * D;
        float4 v[8]; float s = 0.f;
#pragma unroll
        for (int i = 0; i < 8; ++i) { const int c = (i * 64 + lane) * 4;
            const float4 x = *(const float4*)(xr + c), g = *(const float4*)(mod + 4096 + c);
            float4 m;
            if (row < MP) { const u32x2 mb = *(const u32x2*)(mr + c); m = make_float4(bf_lo(mb.x), bf_hi(mb.x), bf_lo(mb.y), bf_hi(mb.y)); }
            else { m = make_float4(0.f, 0.f, 0.f, 0.f);
#pragma unroll
                for (int ks = 0; ks < 8; ++ks) { const float4 q4 = *(const float4*)(PO + ((size_t)ks * MS + (row - MP)) * D + c); m.x += q4.x; m.y += q4.y; m.z += q4.z; m.w += q4.w; } }
            v[i].x = ALPHA * x.x + (1.0f + g.x) * m.x; v[i].y = ALPHA * x.y + (1.0f + g.y) * m.y; v[i].z = ALPHA * x.z + (1.0f + g.z) * m.z; v[i].w = ALPHA * x.w + (1.0f + g.w) * m.w;
            s += (v[i].x + v[i].y) + (v[i].z + v[i].w); }
        float mu = wave_sum(s) * (1.0f / 2048.0f); float q = 0.f;
#pragma unroll
        for (int i = 0; i < 8; ++i) { const float a = v[i].x - mu, b = v[i].y - mu, c = v[i].z - mu, d = v[i].w - mu; q += (a * a + b * b) + (c * c + d * d); }
        float rstd = rsqrtf(wave_sum(q) * (1.0f / 2048.0f) + LN_EPS);
        s = 0.f;
#pragma unroll
        for (int i = 0; i < 8; ++i) { const int c = (i * 64 + lane) * 4;
            const float4 gg = *(const float4*)(lg + c), bb = *(const float4*)(lb + c);
            v[i].x = (v[i].x - mu) * rstd * gg.x + bb.x; v[i].y = (v[i].y - mu) * rstd * gg.y + bb.y; v[i].z = (v[i].z - mu) * rstd * gg.z + bb.z; v[i].w = (v[i].w - mu) * rstd * gg.w + bb.w;
            { u32x2 xb; xb.x = cvt_pk_bf16(v[i].x, v[i].y); xb.y = cvt_pk_bf16(v[i].z, v[i].w); *(u32x2*)(X1 + (size_t)row * D + c) = xb; }
            s += (v[i].x + v[i].y) + (v[i].z + v[i].w); }
        mu = wave_sum(s) * (1.0f / 2048.0f); q = 0.f;
#pragma unroll
        for (int i = 0; i < 8; ++i) { const float a = v[i].x - mu, b = v[i].y - mu, c = v[i].z - mu, d = v[i].w - mu; q += (a * a + b * b) + (c * c + d * d); }
        rstd = rsqrtf(wave_sum(q) * (1.0f / 2048.0f) + LN_EPS);
#pragma unroll
        for (int i = 0; i < 8; ++i) { const int c = (i * 64 + lane) * 4;
            const float4 sh = *(const float4*)(mod + 6144 + c), sc = *(const float4*)(mod + 8192 + c);
            u32x2 o;
            o.x = cvt_pk_bf16((v[i].x - mu) * rstd * (1.0f + sc.x) + sh.x, (v[i].y - mu) * rstd * (1.0f + sc.y) + sh.y);
            o.y = cvt_pk_bf16((v[i].z - mu) * rstd * (1.0f + sc.z) + sh.z, (v[i].w - mu) * rstd * (1.0f + sc.w) + sh.w);
            *(u32x2*)(U + (size_t)row * D + c) = o; }
    }
}

DI void ffn_one(const float* z0, const float* z1, const float* z2, const float* gv, const float* w0, const float* w1, const float* w2, bf16_t* dst) {
    float y[8];
#pragma unroll
    for (int e = 0; e < 8; ++e) { const float ac = w0[e] * z0[e] + w1[e] * z1[e] + w2[e] * z2[e]; y[e] = siluf_(ac) * gv[e]; }
    *(u32x4*)dst = pack8(y);
}
DI void phase7(const Params& p) {
    const bf16_t* UP = (const bf16_t*)(p.ws + OFF_UP);
    bf16_t* HM = (bf16_t*)(p.ws + OFF_HMID);
    const float* wf = p.in[19];
    const int gtid = blockIdx.x * 512 + tidx(), gsz = gridDim.x * 512;
    const int nwalk = (MP / 16) * 704;
    for (int wk = gtid; wk < nwalk; wk += gsz) {
        const int rb = wk / 704, c8 = (wk - rb * 704) * 8, row0 = rb * 16, tp0 = row0 & 2047;
        float w0[8], w1[8], w2[8];
        { const float4 a0 = *(const float4*)(wf + c8), a1 = *(const float4*)(wf + c8 + 4);
          const float4 b0 = *(const float4*)(wf + DFF + c8), b1 = *(const float4*)(wf + DFF + c8 + 4);
          const float4 c0 = *(const float4*)(wf + 2 * DFF + c8), c1 = *(const float4*)(wf + 2 * DFF + c8 + 4);
          w0[0] = a0.x; w0[1] = a0.y; w0[2] = a0.z; w0[3] = a0.w; w0[4] = a1.x; w0[5] = a1.y; w0[6] = a1.z; w0[7] = a1.w;
          w1[0] = b0.x; w1[1] = b0.y; w1[2] = b0.z; w1[3] = b0.w; w1[4] = b1.x; w1[5] = b1.y; w1[6] = b1.z; w1[7] = b1.w;
          w2[0] = c0.x; w2[1] = c0.y; w2[2] = c0.z; w2[3] = c0.w; w2[4] = c1.x; w2[5] = c1.y; w2[6] = c1.z; w2[7] = c1.w; }
        float zm2[8], zm1[8];
        if (tp0 == 0) {
#pragma unroll
            for (int e = 0; e < 8; ++e) { zm2[e] = 0.f; zm1[e] = 0.f; }
        } else {
            unpack8(*(const u32x4*)(UP + (size_t)(row0 - 2) * NUP + c8), zm2);
            unpack8(*(const u32x4*)(UP + (size_t)(row0 - 1) * NUP + c8), zm1);
        }
        for (int q = 0; q < 16; q += 4) {
            u32x4 av[4], gv4[4];
#pragma unroll
            for (int k = 0; k < 4; ++k) { const bf16_t* pr = UP + (size_t)(row0 + q + k) * NUP + c8; av[k] = *(const u32x4*)pr; gv4[k] = *(const u32x4*)(pr + DFF); }
#pragma unroll
            for (int k = 0; k < 4; ++k) {
                float z[8], g[8]; unpack8(av[k], z); unpack8(gv4[k], g);
                ffn_one(zm2, zm1, z, g, w0, w1, w2, HM + (size_t)(row0 + q + k) * DFF + c8);
#pragma unroll
                for (int e = 0; e < 8; ++e) { zm2[e] = zm1[e]; zm1[e] = z[e]; }
            }
        }
        if (tp0 + 16 == 2048) {
            float* o = p.out + O_PFFN + (size_t)((row0 >> 11) * 2) * DFF + c8;
            *(float4*)(o) = make_float4(zm2[0], zm2[1], zm2[2], zm2[3]); *(float4*)(o + 4) = make_float4(zm2[4], zm2[5], zm2[6], zm2[7]);
            *(float4*)(o + DFF) = make_float4(zm1[0], zm1[1], zm1[2], zm1[3]); *(float4*)(o + DFF + 4) = make_float4(zm1[4], zm1[5], zm1[6], zm1[7]);
        }
    }
    const int total = MS * 704;
    for (int idx = gtid; idx < total; idx += gsz) {
        const int rr = idx / 704, c8 = (idx - rr * 704) * 8, row = MP + rr;
        const int b = rr >> 2, tp = rr & 3;
        float z[3][8];
#pragma unroll
        for (int j = 0; j < 3; ++j) {
            const int tq = tp - 2 + j;
            if (tq >= 0) unpack8(*(const u32x4*)(UP + (size_t)(row - 2 + j) * NUP + c8), z[j]);
            else { const float* sp = p.in[8] + (size_t)(b * 2 + tq + 2) * DFF + c8;
                const float4 s0 = *(const float4*)sp, s1 = *(const float4*)(sp + 4);
                z[j][0] = s0.x; z[j][1] = s0.y; z[j][2] = s0.z; z[j][3] = s0.w; z[j][4] = s1.x; z[j][5] = s1.y; z[j][6] = s1.z; z[j][7] = s1.w; }
        }
        float gv[8];
        unpack8(*(const u32x4*)(UP + (size_t)row * NUP + DFF + c8), gv);
        const float4 w0a = *(const float4*)(wf + c8), w0b = *(const float4*)(wf + c8 + 4);
        const float4 w1a = *(const float4*)(wf + DFF + c8), w1b = *(const float4*)(wf + DFF + c8 + 4);
        const float4 w2a = *(const float4*)(wf + 2 * DFF + c8), w2b = *(const float4*)(wf + 2 * DFF + c8 + 4);
        const float w0[8] = {w0a.x, w0a.y, w0a.z, w0a.w, w0b.x, w0b.y, w0b.z, w0b.w};
        const float w1[8] = {w1a.x, w1a.y, w1a.z, w1a.w, w1b.x, w1b.y, w1b.z, w1b.w};
        const float w2[8] = {w2a.x, w2a.y, w2a.z, w2a.w, w2b.x, w2b.y, w2b.z, w2b.w};
        ffn_one(z[0], z[1], z[2], gv, w0, w1, w2, HM + (size_t)row * DFF + c8);
        if (tp == 3) {
            float* o = p.out + O_SFFN + (size_t)(b * 2) * DFF + c8;
            *(float4*)(o) = make_float4(z[1][0], z[1][1], z[1][2], z[1][3]); *(float4*)(o + 4) = make_float4(z[1][4], z[1][5], z[1][6], z[1][7]);
            *(float4*)(o + DFF) = make_float4(z[2][0], z[2][1], z[2][2], z[2][3]); *(float4*)(o + DFF + 4) = make_float4(z[2][4], z[2][5], z[2][6], z[2][7]);
        }
    }
}

DI void phase9(const Params& p) {
    const int t = tidx(), lane = t & 63, w = t >> 6;
    const float* MOD = (const float*)(p.ws + OFF_MOD);
    const bf16_t* Y = (const bf16_t*)(p.ws + OFF_MIX);
    const float* PD = (const float*)(p.ws + OFF_PART_DOWN);
    const bf16_t* X1 = (const bf16_t*)(p.ws + OFF_X1);
    const float* lg = p.in[21]; const float* lb = p.in[22];
    for (int row = blockIdx.x * 8 + w; row < M; row += gridDim.x * 8) {
        const float* mod = MOD + (size_t)mod_row(row) * 12288;
        float4 v[8]; float s = 0.f;
#pragma unroll
        for (int i = 0; i < 8; ++i) { const int c = (i * 64 + lane) * 4;
            const u32x2 xb = *(const u32x2*)(X1 + (size_t)row * D + c);
            const float4 x = make_float4(bf_lo(xb.x), bf_hi(xb.x), bf_lo(xb.y), bf_hi(xb.y)), g = *(const float4*)(mod + 10240 + c);
            float4 m;
            if (row < MP) { const u32x2 mb = *(const u32x2*)(Y + (size_t)row * D + c); m = make_float4(bf_lo(mb.x), bf_hi(mb.x), bf_lo(mb.y), bf_hi(mb.y)); }
            else { m = make_float4(0.f, 0.f, 0.f, 0.f);
#pragma unroll
                for (int ks = 0; ks < 11; ++ks) { const float4 q4 = *(const float4*)(PD + ((size_t)ks * MS + (row - MP)) * D + c); m.x += q4.x; m.y += q4.y; m.z += q4.z; m.w += q4.w; } }
            v[i].x = ALPHA * x.x + (1.0f + g.x) * m.x; v[i].y = ALPHA * x.y + (1.0f + g.y) * m.y; v[i].z = ALPHA * x.z + (1.0f + g.z) * m.z; v[i].w = ALPHA * x.w + (1.0f + g.w) * m.w;
            s += (v[i].x + v[i].y) + (v[i].z + v[i].w); }
        const float mu = wave_sum(s) * (1.0f / 2048.0f); float q = 0.f;
#pragma unroll
        for (int i = 0; i < 8; ++i) { const float a = v[i].x - mu, b = v[i].y - mu, c = v[i].z - mu, d = v[i].w - mu; q += (a * a + b * b) + (c * c + d * d); }
        const float rstd = rsqrtf(wave_sum(q) * (1.0f / 2048.0f) + LN_EPS);
#pragma unroll
        for (int i = 0; i < 8; ++i) { const int c = (i * 64 + lane) * 4;
            const float4 gg = *(const float4*)(lg + c), bb = *(const float4*)(lb + c);
            float4 o;
            o.x = (v[i].x - mu) * rstd * gg.x + bb.x; o.y = (v[i].y - mu) * rstd * gg.y + bb.y; o.z = (v[i].z - mu) * rstd * gg.z + bb.z; o.w = (v[i].w - mu) * rstd * gg.w + bb.w;
            *(float4*)(p.out + (size_t)row * D + c) = o; }
    }
}

#define XB_TMO      128
#define XB_XCNT(j)  (256  + 64 * (j))
#define XB_XSUB(j)  (1280 + 64 * (j))
#define XB_XGEN(j)  (2304 + 64 * (j))
#define XB_TOP      3328
#define XB_TOPGEN   3392
#define XCD_BAR_WORDS 3456
#define XB_SPIN_CAP (1u << 18)
#define XLAS __attribute__((address_space(3)))
DI unsigned xb_ld(unsigned* p)              { return __hip_atomic_load(p, __ATOMIC_RELAXED, __HIP_MEMORY_SCOPE_AGENT); }
DI unsigned xb_add(unsigned* p, unsigned v) { return __hip_atomic_fetch_add(p, v, __ATOMIC_RELAXED, __HIP_MEMORY_SCOPE_AGENT); }
DI unsigned xb_xcc_id() { return (unsigned)__builtin_amdgcn_s_getreg((3 << 11) | 20) & 0xFu; }
#define XB_SPIN(cond, bar) do { unsigned _sp = 0; while (cond) { __builtin_amdgcn_s_sleep(1); \
    if ((++_sp & 255u) == 0u) { if (xb_ld(&(bar)[XB_TMO])) break; if (_sp > XB_SPIN_CAP) { atomicAdd(&(bar)[XB_TMO], 1u); break; } } } } while (0)
struct XcdBarrier { unsigned* bar; unsigned x; volatile XLAS unsigned* st; };
DI XcdBarrier xcd_barrier_post(unsigned* bar, volatile XLAS unsigned* st) {
    XcdBarrier b; b.bar = bar; b.x = xb_xcc_id(); b.st = st;
    if (threadIdx.x == 0) (void)xb_add(&bar[XB_XCNT(b.x)], 1u);
    return b;
}
DI void xcd_barrier_complete(unsigned* bar, unsigned x, unsigned& nloc, unsigned& nx) {
    const unsigned G = gridDim.x * gridDim.y * gridDim.z;
    unsigned sum, cnt, mine, sp = 0u;
    for (;;) {
        sum = 0u; cnt = 0u; mine = 0u;
#pragma unroll
        for (unsigned j = 0; j < 16; ++j) { const unsigned c = xb_ld(&bar[XB_XCNT(j)]); sum += c; cnt += (c > 0u) ? 1u : 0u; mine = (j == x) ? c : mine; }
        if (sum == G) break;
        __builtin_amdgcn_s_sleep(1);
        if ((++sp & 255u) == 0u) { if (xb_ld(&bar[XB_TMO])) break; if (sp > XB_SPIN_CAP) { atomicAdd(&bar[XB_TMO], 1u); break; } }
    }
    nloc = mine > 0u ? mine : 1u; nx = cnt > 0u ? cnt : 1u;
}
DI void xcd_barrier(const XcdBarrier& b) {
    asm volatile("s_waitcnt vmcnt(0)" ::: "memory");
    __syncthreads();
    if (threadIdx.x == 0) {
        unsigned* bar = b.bar;
        __builtin_amdgcn_s_waitcnt(0);
        unsigned nloc = b.st[0], nx = b.st[1];
        if (nloc == 0u) { xcd_barrier_complete(bar, b.x, nloc, nx); b.st[0] = nloc; b.st[1] = nx; }
        const unsigned old = xb_add(&bar[XB_XSUB(b.x)], 1u);
        const unsigned gen = old / nloc;
        if (old + 1u == (gen + 1u) * nloc) {
            __builtin_amdgcn_fence(__ATOMIC_RELEASE, "agent");
            asm volatile("s_waitcnt vmcnt(0)" ::: "memory");
            const unsigned og = xb_add(&bar[XB_TOP], 1u);
            const unsigned tg = og / nx;
            if (og + 1u == (tg + 1u) * nx) xb_add(&bar[XB_TOPGEN], 1u);
            else XB_SPIN(xb_ld(&bar[XB_TOPGEN]) == tg, bar);
            __builtin_amdgcn_fence(__ATOMIC_ACQUIRE, "agent");
            xb_add(&bar[XB_XGEN(b.x)], 1u);
            asm volatile("s_waitcnt vmcnt(0)" ::: "memory");
        } else {
            XB_SPIN(xb_ld(&bar[XB_XGEN(b.x)]) == gen, bar);
            __builtin_amdgcn_fence(__ATOMIC_ACQUIRE, "agent");
            asm volatile("s_waitcnt vmcnt(0)" ::: "memory");
        }
    }
    __syncthreads();
}

__global__ void __launch_bounds__(512, 2) fwd_megakernel(Params p) {
    extern __shared__ __attribute__((aligned(16))) unsigned char shm[];
    cg::grid_group grid = cg::this_grid();
    const int lo = p.ph_lo, hi = p.ph_hi;
    if (threadIdx.x < 4) ((volatile unsigned*)(shm + LDS_SLOT + 16))[threadIdx.x] = 0u;
    __syncthreads();
    XcdBarrier xbar; xbar.bar = (unsigned*)(p.ws + OFF_CTL + 4096); xbar.x = 0; xbar.st = (volatile XLAS unsigned*)(shm + LDS_SLOT + 16);
    if (hi - lo > 1) xbar = xcd_barrier_post((unsigned*)(p.ws + OFF_CTL + 4096), (volatile XLAS unsigned*)(shm + LDS_SLOT + 16));
    if (lo < 0) grid.sync();
#define IN(k) (lo <= (k) && (k) < hi)
#define SEAM(k) do { if (IN(k) && IN((k) + 1)) { if (DUPMASK & 2048) xcd_barrier(xbar); xcd_barrier(xbar); } } while (0)
    if (IN(0)) { phase0(p, shm, 0); if (DUPMASK & 1) phase0(p, shm, 128); }
    SEAM(0);
    if (IN(1)) { phase1(p, shm); if (DUPMASK & 2) { __syncthreads(); phase1(p, shm); } }
    SEAM(1);
    if (IN(2)) {
        __syncthreads();
        pg8::Gemm g{(const bf16_t*)(p.ws + OFF_U), (const bf16_t*)(p.ws + OFF_WT_IN), M, NP, D, D, D};
        pg8::StaticOrder S; S.init(M, NP, (int)gridDim.x, (int)blockIdx.x);
        pg8::EpiBf16 E{(bf16_t*)(p.ws + OFF_P), NP};
        pg8::gemm_phase<pg8::EpiBf16, pg8::StaticOrder>((PG8_LAS unsigned char*)shm, g, S, E);
        {
            const int nun = (M / 256) * (NP / 256), G = (int)gridDim.x, rounds = (nun + G - 1) / G;
            if (nun % G == 0 || (rounds - 1) * G + (int)blockIdx.x >= nun) phase2_idle(p, shm, 256);
        }
    }
    SEAM(2);
    if (IN(3)) { phase3(p, shm, 64); if (DUPMASK & 8) phase3(p, shm, 192); }
    SEAM(3);
    if (IN(4)) { phase3b(p); if (DUPMASK & 16) phase3b(p); }
    SEAM(4);
    if (IN(5)) {
        __syncthreads();
        pg8::Gemm g{(const bf16_t*)(p.ws + OFF_MIXIN), (const bf16_t*)(p.ws + OFF_WT_OUT), MP, D, D, D, D};
        pg8::StaticOrder S; S.init(MP, D, (int)gridDim.x, (int)blockIdx.x);
        pg8::EpiBf16 E{(bf16_t*)(p.ws + OFF_MIX), D};
        pg8::gemm_phase<pg8::EpiBf16, pg8::StaticOrder>((PG8_LAS unsigned char*)shm, g, S, E);
        pg8::Gemm g2{(const bf16_t*)(p.ws + OFF_MIXIN) + (size_t)MP * D, (const bf16_t*)(p.ws + OFF_WT_OUT), MS, D, 256, D, D};
        pg8::SplitOrder S2; S2.init(8, 256, (int)gridDim.x, (int)blockIdx.x);
        pg8::EpiF32 E2{(float*)(p.ws + OFF_PART_OUT), D, (size_t)MS * D};
        pg8::gemm_phase<pg8::EpiF32, pg8::SplitOrder>((PG8_LAS unsigned char*)shm, g2, S2, E2);
    }
    SEAM(5);
    if (IN(6)) { phase5(p); if (DUPMASK & 64) phase5(p); }
    SEAM(6);
    if (IN(7)) {
        __syncthreads();
        pg8::Gemm g{(const bf16_t*)(p.ws + OFF_U), (const bf16_t*)(p.ws + OFF_WT_UP), M, NUP, D, D, D};
        pg8::StaticOrder S; S.init(M, NUP, (int)gridDim.x, (int)blockIdx.x);
        pg8::EpiBf16 E{(bf16_t*)(p.ws + OFF_UP), NUP};
        pg8::gemm_phase<pg8::EpiBf16, pg8::StaticOrder>((PG8_LAS unsigned char*)shm, g, S, E);
    }
    SEAM(7);
    if (IN(8)) { phase7(p); if (DUPMASK & 256) phase7(p); }
    SEAM(8);
    if (IN(9)) {
        __syncthreads();
        pg8::Gemm g{(const bf16_t*)(p.ws + OFF_HMID), (const bf16_t*)(p.ws + OFF_WT_DOWN), MP, D, DFF, DFF, DFF};
        pg8::StaticOrder S; S.init(MP, D, (int)gridDim.x, (int)blockIdx.x);
        pg8::EpiBf16 E{(bf16_t*)(p.ws + OFF_MIX), D};
        pg8::gemm_phase<pg8::EpiBf16, pg8::StaticOrder>((PG8_LAS unsigned char*)shm, g, S, E);
        pg8::Gemm g2{(const bf16_t*)(p.ws + OFF_HMID) + (size_t)MP * DFF, (const bf16_t*)(p.ws + OFF_WT_DOWN), MS, D, 512, DFF, DFF};
        pg8::SplitOrder S2; S2.init(11, 512, (int)gridDim.x, (int)blockIdx.x);
        pg8::EpiF32 E2{(float*)(p.ws + OFF_PART_DOWN), D, (size_t)MS * D};
        pg8::gemm_phase<pg8::EpiF32, pg8::SplitOrder>((PG8_LAS unsigned char*)shm, g2, S2, E2);
    }
    SEAM(9);
    if (IN(10)) { phase9(p); if (DUPMASK & 1024) phase9(p); }
#undef IN
#undef SEAM
}
constexpr int N_PHASES = 11;

extern "C" void kernel_launch(void* const* d_in, const int* in_sizes, int n_in, void* d_out, int out_size, void* d_ws, size_t ws_size, hipStream_t stream) {
    static int grid_blocks = 0;
    if (grid_blocks == 0) {
        if (n_in != 23 || ws_size < WS_END) { fprintf(stderr, "kernel_launch: unexpected n_in %d or ws_size %zu (< %zu)\n", n_in, ws_size, (size_t)WS_END); grid_blocks = -1; return; }
        int dev = 0, cus = 0, per_cu = 0;
        hipGetDevice(&dev);
        hipDeviceGetAttribute(&cus, hipDeviceAttributeMultiprocessorCount, dev);
        if (hipFuncSetAttribute((const void*)fwd_megakernel, hipFuncAttributeMaxDynamicSharedMemorySize, LDS_BYTES) != hipSuccess) { fprintf(stderr, "kernel_launch: hipFuncSetAttribute failed\n"); grid_blocks = -1; return; }
        hipOccupancyMaxActiveBlocksPerMultiprocessor(&per_cu, (const void*)fwd_megakernel, 512, LDS_BYTES);
        if (per_cu < 1) { fprintf(stderr, "kernel_launch: occupancy query says %d blocks per CU\n", per_cu); per_cu = 1; }
        grid_blocks = cus * per_cu;
        (void)hipGetLastError();
    }
    if (grid_blocks < 0) return;
    (void)hipMemsetAsync((char*)d_ws + OFF_CTL, 0, CTL_BYTES, stream);
    Params p{};
    for (int i = 0; i < 23; ++i) p.in[i] = (const float*)d_in[i];
    p.out = (float*)d_out; p.ws = (unsigned char*)d_ws;
#if MK_MULTI
    for (int ph = 0; ph < N_PHASES; ++ph) {
        p.ph_lo = ph; p.ph_hi = ph + 1;
        hipLaunchKernelGGL(fwd_megakernel, dim3(grid_blocks), dim3(512), LDS_BYTES, stream, p);
    }
#else
    p.ph_lo = 0; p.ph_hi = N_PHASES;
    void* args[] = {&p};
    hipError_t e = hipLaunchCooperativeKernel((const void*)fwd_megakernel, dim3(grid_blocks), dim3(512), args, LDS_BYTES, stream);
    if (e != hipSuccess) fprintf(stderr, "cooperative launch failed: %s (grid %d)\n", hipGetErrorString(e), grid_blocks);
#endif
}
```
